# Optimizing an MI355X kernel written in HIP

```python
import math
import jax, jax.numpy as jnp
from jax import lax
import numpy as np

D_MODEL = 1024
BATCH = 32
SEQ = 2048
DEPTH = 4

CHUNK = 64
MIX_WIDTH = D_MODEL
SB_HEADS = 8
SB_HEAD_DIM = 64
SB_WIDTH = SB_HEADS * SB_HEAD_DIM
SB_BLOCK = 128
POOL_WINDOWS = (2, 4, 8, 16)
POOL_GROUPS = len(POOL_WINDOWS)
POOL_GROUP_DIM = 64
POOL_WIDTH = POOL_GROUPS * POOL_GROUP_DIM
CONV_WIDTH = MIX_WIDTH - SB_WIDTH - POOL_WIDTH
CONV_KERNEL = 31
IN_COLS = 3 * SB_WIDTH + POOL_WIDTH + 2 * CONV_WIDTH
FFN_HIDDEN = int(math.ceil((8 * D_MODEL / 3) / 256) * 256)
RMS_EPS = 1e-6
LN_EPS = 1e-5

kernel_name = "hybrid_sb_pool_conformer_trunk"


def _rmsnorm(x, g):
    xf = x.astype(jnp.float32)
    y = xf * lax.rsqrt(jnp.mean(xf * xf, axis=-1, keepdims=True) + RMS_EPS)
    return (y * g.astype(jnp.float32)).astype(x.dtype)


def _layernorm(x, g, b):
    xf = x.astype(jnp.float32)
    mu = jnp.mean(xf, axis=-1, keepdims=True)
    var = jnp.mean(jnp.square(xf - mu), axis=-1, keepdims=True)
    y = (xf - mu) * lax.rsqrt(var + LN_EPS)
    return (y * g.astype(jnp.float32) + b.astype(jnp.float32)).astype(x.dtype)


def _stick_breaking_attention(q, k, v):
    b, t, h, dh = q.shape
    scale = 1.0 / math.sqrt(dh)
    qh = jnp.transpose(q, (0, 2, 1, 3))
    kh = jnp.transpose(k, (0, 2, 1, 3))
    vh = jnp.transpose(v, (0, 2, 1, 3)).astype(jnp.float32)
    outs = []
    for i in range(t // SB_BLOCK):
        q0 = i * SB_BLOCK
        k_end = q0 + SB_BLOCK
        qb = qh[:, :, q0:k_end]
        kb = kh[:, :, :k_end]
        vb = vh[:, :, :k_end]
        z = jnp.einsum('bhqd,bhkd->bhqk', qb, kb).astype(jnp.float32) * scale
        t_idx = q0 + jnp.arange(SB_BLOCK)[:, None]
        s_idx = jnp.arange(k_end)[None, :]
        strict = s_idx < t_idx
        log_beta = jax.nn.log_sigmoid(z)
        log_1mb = jnp.where(strict, jax.nn.log_sigmoid(-z), 0.0)
        suffix = lax.cumsum(log_1mb, axis=3, reverse=True) - log_1mb
        w = jnp.where(strict, jnp.exp(log_beta + suffix), 0.0)
        outs.append(jnp.einsum('bhqk,bhkd->bhqd', w, vb))
    o = jnp.concatenate(outs, axis=2)
    return jnp.transpose(o, (0, 2, 1, 3)).reshape(b, t, h * dh)


def _multiscale_pool(u, pool_w, pool_scale):
    b, t, _ = u.shape
    uf = u.astype(jnp.float32).reshape(b, t, POOL_GROUPS, POOL_GROUP_DIM)
    cs = jnp.cumsum(uf, axis=1)
    pos = jnp.arange(t, dtype=jnp.float32)[None, :, None]
    pooled = []
    for g, w in enumerate(POOL_WINDOWS):
        csg = cs[:, :, g]
        shifted = jnp.pad(csg, ((0, 0), (w, 0), (0, 0)))[:, :t]
        count = jnp.minimum(pos + 1.0, float(w))
        pooled.append((csg - shifted) / count - uf[:, :, g])
    p = jnp.stack(pooled, axis=2)
    y = jnp.einsum('btgc,gcd->btgd', p, pool_w.astype(jnp.float32))
    y = y.reshape(b, t, POOL_WIDTH) * pool_scale.astype(jnp.float32)
    return y.astype(u.dtype)


def _conformer_conv(u, conv_w, conv_b, ln_g, ln_b, pw_out):
    a, gate = jnp.split(u, 2, axis=-1)
    h = a * jax.nn.sigmoid(gate)
    kern = conv_w[:, None, :].astype(h.dtype)
    h = lax.conv_general_dilated(
        h, kern, window_strides=(1,), padding=[(CONV_KERNEL - 1, 0)],
        dimension_numbers=('NWC', 'WIO', 'NWC'), feature_group_count=CONV_WIDTH)
    h = h + conv_b
    h = _layernorm(h, ln_g, ln_b)
    h = jax.nn.silu(h)
    return jnp.einsum('btc,cd->btd', h, pw_out)


def setup_inputs(seed: int = 0) -> dict:
    key = jax.random.key(seed)
    ks = jax.random.split(key, 20)
    f32 = jnp.float32

    def nrm(k, shape, scale):
        return jax.random.normal(k, shape, f32) * scale

    return {
        "x": nrm(ks[0], (BATCH, SEQ, D_MODEL), 1.0),
        "norm_mix_g": 1.0 + nrm(ks[1], (DEPTH, D_MODEL), 0.05),
        "w_in": nrm(ks[2], (DEPTH, D_MODEL, IN_COLS), D_MODEL ** -0.5),
        "sb_q_g": 1.0 + nrm(ks[3], (DEPTH, SB_HEAD_DIM), 0.05),
        "sb_k_g": 1.0 + nrm(ks[4], (DEPTH, SB_HEAD_DIM), 0.05),
        "pool_w": nrm(ks[5], (DEPTH, POOL_GROUPS, POOL_GROUP_DIM, POOL_GROUP_DIM), POOL_GROUP_DIM ** -0.5),
        "pool_scale": 1.0 + nrm(ks[6], (DEPTH, POOL_WIDTH), 0.1),
        "conv_w": nrm(ks[7], (DEPTH, CONV_KERNEL, CONV_WIDTH), CONV_KERNEL ** -0.5),
        "conv_b": nrm(ks[8], (DEPTH, CONV_WIDTH), 0.02),
        "conv_ln_g": 1.0 + nrm(ks[9], (DEPTH, CONV_WIDTH), 0.05),
        "conv_ln_b": nrm(ks[10], (DEPTH, CONV_WIDTH), 0.02),
        "conv_pw": nrm(ks[11], (DEPTH, CONV_WIDTH, CONV_WIDTH), CONV_WIDTH ** -0.5),
        "w_out": nrm(ks[12], (DEPTH, MIX_WIDTH, D_MODEL), MIX_WIDTH ** -0.5),
        "norm_ffn_g": 1.0 + nrm(ks[13], (DEPTH, D_MODEL), 0.05),
        "ffn_w_gu": nrm(ks[14], (DEPTH, D_MODEL, 2 * FFN_HIDDEN), D_MODEL ** -0.5),
        "ffn_w_down": nrm(ks[15], (DEPTH, FFN_HIDDEN, D_MODEL), FFN_HIDDEN ** -0.5),
    }


def reference(x, norm_mix_g, w_in, sb_q_g, sb_k_g, pool_w, pool_scale, conv_w, conv_b,
              conv_ln_g, conv_ln_b, conv_pw, w_out, norm_ffn_g, ffn_w_gu, ffn_w_down):
    b, t, _ = x.shape
    split_pts = [SB_WIDTH, 2 * SB_WIDTH, 3 * SB_WIDTH, 3 * SB_WIDTH + POOL_WIDTH]
    for l in range(DEPTH):
        h = _rmsnorm(x, norm_mix_g[l])
        proj = jnp.einsum('btd,de->bte', h, w_in[l])
        q, k, v, u_pool, u_conv = jnp.split(proj, split_pts, axis=-1)
        q = _rmsnorm(q.reshape(b, t, SB_HEADS, SB_HEAD_DIM).astype(jnp.float32), sb_q_g[l])
        k = _rmsnorm(k.reshape(b, t, SB_HEADS, SB_HEAD_DIM).astype(jnp.float32), sb_k_g[l])
        v = v.reshape(b, t, SB_HEADS, SB_HEAD_DIM)
        a_out = _stick_breaking_attention(q, k, v).astype(x.dtype)
        p_out = _multiscale_pool(u_pool, pool_w[l], pool_scale[l])
        c_out = _conformer_conv(u_conv, conv_w[l], conv_b[l], conv_ln_g[l],
                                conv_ln_b[l], conv_pw[l]).astype(x.dtype)
        mix = jnp.concatenate([a_out, p_out, c_out], axis=-1)
        x = x + jnp.einsum('btm,md->btd', mix, w_out[l])
        h2 = _rmsnorm(x, norm_ffn_g[l])
        gu = jnp.einsum('btd,df->btf', h2, ffn_w_gu[l])
        g, u = jnp.split(gu, 2, axis=-1)
        x = x + jnp.einsum('btf,fd->btd', jax.nn.silu(g) * u, ffn_w_down[l])
    return x
```

```cpp
#define MK_ONE_LAUNCH 1
#include <hip/hip_runtime.h>
#include <hip/hip_cooperative_groups.h>
#include <cstdio>
#include <cstdint>
namespace cg = cooperative_groups;
namespace pg8 {
#define PG8_LAS __attribute__((address_space(3)))
typedef unsigned short bf16_t;
typedef short bf16x8 __attribute__((ext_vector_type(8)));
typedef float f32x4 __attribute__((ext_vector_type(4)));
typedef unsigned u32x4 __attribute__((ext_vector_type(4)));
constexpr int BM = 256, BK = 64, HALF = 128, HTB = HALF * BK * 2  , STAGE_BYTES = 8 * HTB, NXCD = 8, WGM = 8;

__host__ __device__ __forceinline__ int lds_byte(int r, int c) { const int st = (r >> 4) * 2 + (c >> 5), rr = r & 15, cc = c & 31, ob = rr * 64 + cc * 2; return st * 1024 + (ob ^ (((ob >> 9) & 1) << 5)); }
__host__ __device__ __forceinline__ void stage_rc(int b, int& R, int& C) { const int st = b / 1024, sb = b % 1024, swz = sb ^ (((sb >> 9) & 1) << 5); R = (st >> 1) * 16 + swz / 64; C = (st & 1) * 32 + (swz % 64) / 2; }
__host__ __device__ __forceinline__ int perm32(int rho) { const int n = rho >> 4, i = rho & 15; return 8 * (i >> 2) + 4 * n + (i & 3); }

struct Unit { int pm, pn; };
struct Gemm { const bf16_t* A; const bf16_t* Bt; int M, N, K; };

struct StaticOrder {
    int nM, nN, nwg, G, c;
    __host__ __device__ void init(int M, int N, int G_, int c_) { nM = M / BM; nN = N / BM; nwg = nM * nN; G = G_; c = c_; }
    __host__ __device__ bool next(int i, Unit& u) const {
        const long L = (long)i * G + c; if (L >= nwg) return false;
        int wgid = (int)L; { const int q = nwg / NXCD, r = nwg % NXCD, xcd = wgid % NXCD, off = wgid / NXCD; wgid = (xcd < r ? xcd * (q + 1) : r * (q + 1) + (xcd - r) * q) + off; }
        const int nig = WGM * nN, gid = wgid / nig, fm = gid * WGM, gsz = (nM - fm) < WGM ? (nM - fm) : WGM;
        u.pm = fm + ((wgid % nig) % gsz); u.pn = (wgid % nig) / gsz; return true;
    }
    __device__ __forceinline__ void a_ready(const Unit&) const {}
    __device__ __forceinline__ void done(const Unit&) const {}
};
typedef float f32x2 __attribute__((ext_vector_type(2))); typedef __bf16 pg8_bf16x2 __attribute__((ext_vector_type(2)));
__device__ __forceinline__ unsigned cvt_pk_bf16(float lo, float hi) { const f32x2 v = {lo, hi}; const pg8_bf16x2 b = __builtin_convertvector(v, pg8_bf16x2); return __builtin_bit_cast(unsigned, b); }
typedef unsigned u32x4 __attribute__((ext_vector_type(4)));
__device__ __forceinline__ void row_rstd(const float* ss, int row0, int fq, float (&rs)[2][4]) {
#pragma unroll
    for (int ai = 0; ai < 2; ++ai)
#pragma unroll
        for (int m = 0; m < 4; ++m) {
            const f32x4 v = *(const f32x4*)(ss + (size_t)(row0 + ai * HALF + m * 16) * 16 + 4 * fq);
            float s = (v[0] + v[1]) + (v[2] + v[3]);
            s += __shfl_xor(s, 16); s += __shfl_xor(s, 32);
            rs[ai][m] = 1.0f / sqrtf(s * (1.0f / 1024.0f) + 1e-6f);
        }
}
struct EpiInProj {
    static constexpr bool PERM = true, AFTER_DRAIN = false;
    bf16_t* P; const float* ss; const float* qg; const float* kg;
    __device__ __forceinline__ void operator()(const f32x4 (&acc)[2][2][4][2], const Unit& u, int wr, int wc, int fr, int fq) const {
        const int row0 = u.pm * BM + wr * 64 + fr;
        float rs[2][4]; row_rstd(ss, row0, fq, rs);
        if (u.pn >= 7) {
#pragma unroll
            for (int ai = 0; ai < 2; ++ai)
#pragma unroll
                for (int m = 0; m < 4; ++m) { const float r = rs[ai][m]; f32x4 h[2];
#pragma unroll
                    for (int n = 0; n < 2; ++n) { const f32x4 a = acc[ai][0][m][n] * r, gt = acc[ai][1][m][n] * r;
#pragma unroll
                        for (int i = 0; i < 4; ++i) h[n][i] = a[i] * __builtin_amdgcn_rcpf(1.0f + __builtin_amdgcn_exp2f(-1.4426950408889634f * gt[i])); }
                    u32x4 w; w.x = cvt_pk_bf16(h[0][0], h[0][1]); w.y = cvt_pk_bf16(h[0][2], h[0][3]); w.z = cvt_pk_bf16(h[1][0], h[1][1]); w.w = cvt_pk_bf16(h[1][2], h[1][3]);
                    *(u32x4*)(P + (size_t)(row0 + ai * HALF + m * 16) * 2304 + 1792 + 128 * (u.pn - 7) + 32 * wc + 8 * fq) = w; }
            return;
        }
        const bool isq = u.pn < 2, isk = (u.pn >= 2 && u.pn < 4), hn = isq || isk;
        f32x4 gv[2][2];
#pragma unroll
        for (int bj = 0; bj < 2; ++bj)
#pragma unroll
            for (int n = 0; n < 2; ++n) gv[bj][n] = (f32x4){1.f, 1.f, 1.f, 1.f};
        if (hn) { const float* g = isq ? qg : kg; const float sc = isq ? 0.125f * 1.4426950408889634f : 1.0f;
#pragma unroll
            for (int bj = 0; bj < 2; ++bj)
#pragma unroll
                for (int n = 0; n < 2; ++n) gv[bj][n] = *(const f32x4*)(g + 32 * bj + 8 * fq + 4 * n) * sc; }
#pragma unroll
        for (int ai = 0; ai < 2; ++ai)
#pragma unroll
            for (int m = 0; m < 4; ++m) {
                const float r = rs[ai][m];
                f32x4 v[2][2];
#pragma unroll
                for (int bj = 0; bj < 2; ++bj)
#pragma unroll
                    for (int n = 0; n < 2; ++n) v[bj][n] = acc[ai][bj][m][n] * r;
                if (hn) {
                    float q = 0.f;
#pragma unroll
                    for (int bj = 0; bj < 2; ++bj)
#pragma unroll
                        for (int n = 0; n < 2; ++n) { const f32x4 x = v[bj][n]; q += (x[0] * x[0] + x[1] * x[1]) + (x[2] * x[2] + x[3] * x[3]); }
                    q += __shfl_xor(q, 16); q += __shfl_xor(q, 32);
                    const float hr = 1.0f / sqrtf(q * (1.0f / 64.0f) + 1e-6f);
#pragma unroll
                    for (int bj = 0; bj < 2; ++bj)
#pragma unroll
                        for (int n = 0; n < 2; ++n) v[bj][n] = v[bj][n] * hr * gv[bj][n];
                }
                bf16_t* rowp = P + (size_t)(row0 + ai * HALF + m * 16) * 2304 + u.pn * BM + 64 * wc + 8 * fq;
#pragma unroll
                for (int bj = 0; bj < 2; ++bj) { u32x4 w; w.x = cvt_pk_bf16(v[bj][0][0], v[bj][0][1]); w.y = cvt_pk_bf16(v[bj][0][2], v[bj][0][3]); w.z = cvt_pk_bf16(v[bj][1][0], v[bj][1][1]); w.w = cvt_pk_bf16(v[bj][1][2], v[bj][1][3]);
                    *(u32x4*)(rowp + 32 * bj) = w; }
            }
    }
};
__device__ __forceinline__ float u2f(unsigned u) { return __builtin_bit_cast(float, u); }
__device__ __forceinline__ float bf_lo_f(unsigned u) { return __builtin_bit_cast(float, u << 16); }
__device__ __forceinline__ float bf_hi_f(unsigned u) { return __builtin_bit_cast(float, u & 0xffff0000u); }
template <bool IN32, bool OUT32> struct EpiResT {
    static constexpr bool PERM = true, AFTER_DRAIN = false;
    float* out; bf16_t* xb; float* ss;
    __device__ __forceinline__ void operator()(const f32x4 (&acc)[2][2][4][2], const Unit& u, int wr, int wc, int fr, int fq) const {
        const int row0 = u.pm * BM + wr * 64 + fr; const int colb = u.pn * BM + wc * 32 + 8 * fq;
#pragma unroll
        for (int am = 0; am < 4; ++am) { const int ai = am >> 1, mb = (am & 1) * 2;
            u32x4 bv[2][2][2];
#pragma unroll
            for (int mm = 0; mm < 2; ++mm)
#pragma unroll
                for (int bj = 0; bj < 2; ++bj) { const size_t off = (size_t)(row0 + ai * HALF + (mb + mm) * 16) * 1024 + colb + bj * HALF;
                    bv[mm][bj][0] = *(const u32x4*)(xb + off); bv[mm][bj][1] = bv[mm][bj][0]; }
            asm volatile("" ::: "memory");
#pragma unroll
            for (int mm = 0; mm < 2; ++mm) { const int m = mb + mm;
                const int row = row0 + ai * HALF + m * 16; float q = 0.f;
#pragma unroll
                for (int bj = 0; bj < 2; ++bj) {
                    const size_t off = (size_t)row * 1024 + colb + bj * HALF;
                    float x[8];
                    {
#pragma unroll
                        for (int k = 0; k < 4; ++k) { x[2 * k] = bf_lo_f(bv[mm][bj][0][k]); x[2 * k + 1] = bf_hi_f(bv[mm][bj][0][k]); }
                    }
#pragma unroll
                    for (int k = 0; k < 4; ++k) { x[k] += acc[ai][bj][m][0][k]; x[4 + k] += acc[ai][bj][m][1][k]; }
                    if (OUT32) { *(f32x4*)(out + off) = (f32x4){x[0], x[1], x[2], x[3]}; *(f32x4*)(out + off + 4) = (f32x4){x[4], x[5], x[6], x[7]}; }
                    else {
                        u32x4 h;
#pragma unroll
                        for (int k = 0; k < 4; ++k) h[k] = cvt_pk_bf16(x[2 * k], x[2 * k + 1]);
                        *(u32x4*)(xb + off) = h;
#pragma unroll
                        for (int k = 0; k < 8; ++k) q += x[k] * x[k];
                    }
                }
                if (!OUT32) { q += __shfl_xor(q, 16); q += __shfl_xor(q, 32); if (fq == 0) ss[(size_t)row * 16 + 4 * u.pn + wc] = q; }
            }
            asm volatile("" ::: "memory");
        }
    }
};
struct EpiGU {
    static constexpr bool PERM = true, AFTER_DRAIN = false;
    bf16_t* H; const float* ss;
    __device__ __forceinline__ void operator()(const f32x4 (&acc)[2][2][4][2], const Unit& u, int wr, int wc, int fr, int fq) const {
        const int row0 = u.pm * BM + wr * 64 + fr;
        float rs[2][4]; row_rstd(ss, row0, fq, rs);
#pragma unroll
        for (int ai = 0; ai < 2; ++ai)
#pragma unroll
            for (int m = 0; m < 4; ++m) {
                const float r = rs[ai][m]; f32x4 h[2];
#pragma unroll
                for (int n = 0; n < 2; ++n) { const f32x4 g = acc[ai][0][m][n] * r, up = acc[ai][1][m][n] * r;
#pragma unroll
                    for (int i = 0; i < 4; ++i) h[n][i] = g[i] * up[i] * __builtin_amdgcn_rcpf(1.0f + __builtin_amdgcn_exp2f(-1.4426950408889634f * g[i])); }
                u32x4 w; w.x = cvt_pk_bf16(h[0][0], h[0][1]); w.y = cvt_pk_bf16(h[0][2], h[0][3]); w.z = cvt_pk_bf16(h[1][0], h[1][1]); w.w = cvt_pk_bf16(h[1][2], h[1][3]);
                *(u32x4*)(H + (size_t)(row0 + ai * HALF + m * 16) * 2816 + u.pn * HALF + wc * 32 + 8 * fq) = w;
            }
    }
};

struct EpiAny {
    static constexpr bool PERM = true, AFTER_DRAIN = false;
    int kind; bf16_t* ob; const float* ss_in; float* ss_out; float* out; const float* qg; const float* kg;
    __device__ __forceinline__ void operator()(const f32x4 (&acc)[2][2][4][2], const Unit& u, int wr, int wc, int fr, int fq) const {
        if (kind == 0) { EpiInProj e{ob, ss_in, qg, kg}; e(acc, u, wr, wc, fr, fq); }
        else if (kind == 1) { EpiResT<false, false> e{out, ob, ss_out}; e(acc, u, wr, wc, fr, fq); }
        else if (kind == 6) { EpiResT<false, true> e{out, ob, ss_out}; e(acc, u, wr, wc, fr, fq); }
        else { EpiGU e{ob, ss_in}; e(acc, u, wr, wc, fr, fq); }
    }
};
template <class Epi, class Sched, bool ALIGN_EPI = false, bool SP2 = false>
__device__ __forceinline__ void gemm_phase(PG8_LAS unsigned char* lds, const Gemm g, const Sched& S, const Epi& E) {
    int tid_ = threadIdx.x; asm volatile("" : "+v"(tid_)); const int tid = tid_, wid = __builtin_amdgcn_readfirstlane(tid >> 6), lane = tid & 63, wr = wid >> 2, wc = wid & 3, fr = lane & 15, fq = lane >> 4;
    const int K = g.K, nt = K / BK;
    unsigned voffA[2], voffB[2];
#pragma unroll
    for (int i = 0; i < 2; ++i) { int R, C; stage_rc(tid * 16 + i * 8192, R, C); const int Rb = Epi::PERM ? ((R & ~31) + perm32(R & 31)) : R;
        voffA[i] = (unsigned)(R * K + C) * 2u; voffB[i] = (unsigned)(Rb * K + C) * 2u; }
    const size_t kstep = (size_t)(BK * 2);
    const size_t hstep = (size_t)HALF * K * 2;
    const size_t tstep = 2 * hstep;
    const unsigned ldsw = (unsigned)wid * 1024u;
    const int aoff = lds_byte(wr * 64 + fr, fq * 8), boff = lds_byte(wc * 32 + fr, fq * 8);
#define PG8_SA(b, h) (((b) * 2 + (h)) * HTB)
#define PG8_SB(b, h) ((4 + (b) * 2 + (h)) * HTB)
#define PG8_STAGE(bufoff, gbase, voff) do { _Pragma("unroll") for (int _i = 0; _i < 2; ++_i) \
        __builtin_amdgcn_global_load_lds((const unsigned*)((const char*)(gbase) + (voff)[_i]), (PG8_LAS unsigned*)(lds + (bufoff) + ldsw + _i * 8192), 16, 0, 0); } while (0)
#define PG8_LDA(dst, b, h) do { _Pragma("unroll") for (int m = 0; m < 4; ++m) _Pragma("unroll") for (int k = 0; k < 2; ++k) dst[m][k] = *(const PG8_LAS bf16x8*)(lds + PG8_SA(b, h) + aoff + m * 2048 + k * 1024); } while (0)
#define PG8_LDB(dst, b, h) do { _Pragma("unroll") for (int n = 0; n < 2; ++n) _Pragma("unroll") for (int k = 0; k < 2; ++k) dst[n][k] = *(const PG8_LAS bf16x8*)(lds + PG8_SB(b, h) + boff + n * 2048 + k * 1024); } while (0)
#define PG8_MMA(ai, bj, At, Bt) do { __builtin_amdgcn_s_setprio(1); _Pragma("unroll") for (int m = 0; m < 4; ++m) _Pragma("unroll") for (int n = 0; n < 2; ++n) _Pragma("unroll") for (int k = 0; k < 2; ++k) \
        acc[ai][bj][m][n] = __builtin_amdgcn_mfma_f32_16x16x32_bf16(Bt[n][k], At[m][k], acc[ai][bj][m][n], 0, 0, 0); __builtin_amdgcn_s_setprio(0); } while (0)
#define PG8_WAIT_V(n) asm volatile("s_waitcnt vmcnt(" #n ")" ::: "memory")
#define PG8_WAIT_L(n) asm volatile("s_waitcnt lgkmcnt(" #n ")" ::: "memory")
#define PG8_BAR __builtin_amdgcn_s_barrier()
#define PG8_SCHED __builtin_amdgcn_sched_barrier(0)
    Unit cur, nxt; int ui = 0;
    if (!S.next(0, cur)) return;
    f32x4 acc[2][2][4][2];
#pragma unroll
    for (int a = 0; a < 2; ++a)
#pragma unroll
        for (int b = 0; b < 2; ++b)
#pragma unroll
            for (int m = 0; m < 4; ++m)
#pragma unroll
                for (int n = 0; n < 2; ++n) acc[a][b][m][n] = (f32x4){0.f, 0.f, 0.f, 0.f};
    bf16x8 At[4][2], B0[2][2], B1[2][2];
    const char* cA = (const char*)g.A + (size_t)cur.pm * tstep; const char* cB = (const char*)g.Bt + (size_t)cur.pn * tstep;
    S.a_ready(cur);
    if constexpr (SP2) {
        PG8_STAGE(PG8_SB(0, 0), cB, voffB); PG8_STAGE(PG8_SB(0, 1), cB + hstep, voffB); PG8_STAGE(PG8_SA(0, 0), cA, voffA); PG8_STAGE(PG8_SA(0, 1), cA + hstep, voffA);
        if (wr == 1) PG8_BAR;
        PG8_WAIT_V(2); PG8_BAR;
        PG8_STAGE(PG8_SB(1, 0), cB + kstep, voffB); PG8_STAGE(PG8_SA(1, 0), cA + kstep, voffA); PG8_STAGE(PG8_SB(1, 1), cB + hstep + kstep, voffB);
        PG8_WAIT_V(6); PG8_BAR;
    } else {
        PG8_STAGE(PG8_SB(0, 0), cB, voffB); PG8_STAGE(PG8_SA(0, 0), cA, voffA); PG8_STAGE(PG8_SB(0, 1), cB + hstep, voffB); PG8_STAGE(PG8_SA(0, 1), cA + hstep, voffA);
        if (wr == 1) PG8_BAR;
        PG8_WAIT_V(4); PG8_BAR;
        PG8_STAGE(PG8_SB(1, 0), cB + kstep, voffB); PG8_STAGE(PG8_SA(1, 0), cA + kstep, voffA); PG8_STAGE(PG8_SB(1, 1), cB + hstep + kstep, voffB);
        PG8_WAIT_V(6); PG8_BAR;
    }
    for (;;) {
        const bool has_next = S.next(ui + 1, nxt);
        const char* nA = has_next ? (const char*)g.A + (size_t)nxt.pm * tstep : cA; const char* nB = has_next ? (const char*)g.Bt + (size_t)nxt.pn * tstep : cB;
        for (int t = 0; t < nt; t += 2) {
            const bool last = (t == nt - 2);
            const char* a1 = cA + (size_t)(t + 1) * kstep;
            const char* a2 = last ? nA : cA + (size_t)(t + 2) * kstep; const char* b2 = last ? nB : cB + (size_t)(t + 2) * kstep;
            const char* a3 = a2 + kstep; const char* b3 = b2 + kstep;
            if (last && has_next) S.a_ready(nxt);
            if constexpr (SP2) {
            PG8_LDB(B0, 0, 0); PG8_LDB(B1, 0, 1); PG8_SCHED; PG8_LDA(At, 0, 0); PG8_STAGE(PG8_SA(1, 1), a1 + hstep, voffA);
            PG8_WAIT_V(8); PG8_WAIT_L(0); PG8_BAR; PG8_MMA(0, 0, At, B0); PG8_MMA(0, 1, At, B1); PG8_BAR; PG8_SCHED;
            PG8_LDA(At, 0, 1); PG8_STAGE(PG8_SB(0, 0), b2, voffB); PG8_STAGE(PG8_SB(0, 1), b2 + hstep, voffB); PG8_STAGE(PG8_SA(0, 0), a2, voffA);
            PG8_WAIT_V(8); PG8_WAIT_L(0); PG8_BAR; PG8_MMA(1, 0, At, B0); PG8_MMA(1, 1, At, B1); PG8_BAR; PG8_SCHED;
            PG8_LDB(B0, 1, 0); PG8_LDB(B1, 1, 1); PG8_SCHED; PG8_LDA(At, 1, 0); PG8_STAGE(PG8_SA(0, 1), a2 + hstep, voffA);
            PG8_WAIT_V(8); PG8_WAIT_L(0); PG8_BAR; PG8_MMA(0, 0, At, B0); PG8_MMA(0, 1, At, B1); PG8_BAR; PG8_SCHED;
            PG8_LDA(At, 1, 1); PG8_STAGE(PG8_SB(1, 0), b3, voffB); PG8_STAGE(PG8_SB(1, 1), b3 + hstep, voffB); PG8_STAGE(PG8_SA(1, 0), a3, voffA);
            PG8_WAIT_V(8); PG8_WAIT_L(0); PG8_BAR; PG8_MMA(1, 0, At, B0); PG8_MMA(1, 1, At, B1); PG8_BAR; PG8_SCHED;
            } else {
            PG8_LDB(B0, 0, 0); PG8_SCHED; PG8_LDA(At, 0, 0); PG8_STAGE(PG8_SA(1, 1), a1 + hstep, voffA);
            PG8_WAIT_L(8); PG8_BAR; PG8_WAIT_L(0); PG8_MMA(0, 0, At, B0); PG8_BAR; PG8_SCHED;
            PG8_LDB(B1, 0, 1); PG8_STAGE(PG8_SB(0, 0), b2, voffB);
            PG8_BAR; PG8_WAIT_L(0); PG8_MMA(0, 1, At, B1); PG8_BAR;
            PG8_LDA(At, 0, 1); PG8_STAGE(PG8_SA(0, 0), a2, voffA);
            PG8_BAR; PG8_WAIT_L(0); PG8_MMA(1, 0, At, B0); PG8_BAR; PG8_SCHED;
            PG8_STAGE(PG8_SB(0, 1), b2 + hstep, voffB);
            PG8_WAIT_V(6); PG8_BAR; PG8_MMA(1, 1, At, B1); PG8_BAR;
            PG8_LDB(B0, 1, 0); PG8_SCHED; PG8_LDA(At, 1, 0); PG8_STAGE(PG8_SA(0, 1), a2 + hstep, voffA);
            PG8_WAIT_L(8); PG8_BAR; PG8_WAIT_L(0); PG8_MMA(0, 0, At, B0); PG8_BAR; PG8_SCHED;
            PG8_LDB(B1, 1, 1); PG8_STAGE(PG8_SB(1, 0), b3, voffB);
            PG8_BAR; PG8_WAIT_L(0); PG8_MMA(0, 1, At, B1); PG8_BAR;
            PG8_LDA(At, 1, 1); PG8_STAGE(PG8_SA(1, 0), a3, voffA);
            PG8_BAR; PG8_WAIT_L(0); PG8_MMA(1, 0, At, B0); PG8_BAR; PG8_SCHED;
            PG8_STAGE(PG8_SB(1, 1), b3 + hstep, voffB);
            PG8_WAIT_V(6); PG8_BAR; PG8_MMA(1, 1, At, B1); PG8_BAR;
            }
        }
        if constexpr (ALIGN_EPI) { if (wr == 0) PG8_BAR; }
        if constexpr (!Epi::AFTER_DRAIN) { E(acc, cur, wr, wc, fr, fq); S.done(cur); }
        if (!has_next) break;
#pragma unroll
        for (int a = 0; a < 2; ++a)
#pragma unroll
            for (int b = 0; b < 2; ++b)
#pragma unroll
                for (int m = 0; m < 4; ++m)
#pragma unroll
                    for (int n = 0; n < 2; ++n) acc[a][b][m][n] = (f32x4){0.f, 0.f, 0.f, 0.f};
        cur = nxt; cA = nA; cB = nB; ++ui;
        if constexpr (ALIGN_EPI) { if (wr == 1) PG8_BAR; }
    }
    PG8_WAIT_V(0);
    if constexpr (!ALIGN_EPI) { if (wr == 0) PG8_BAR; }
    PG8_BAR;
    if constexpr (Epi::AFTER_DRAIN) { E.fused(acc, cur, wr, wc, fr, fq, lds, wid, lane); S.done(cur); }
#undef PG8_SA
#undef PG8_SB
#undef PG8_STAGE
#undef PG8_LDA
#undef PG8_LDB
#undef PG8_MMA
#undef PG8_WAIT_V
#undef PG8_WAIT_L
#undef PG8_BAR
#undef PG8_SCHED
}
}

#ifndef MK_ONE_LAUNCH
#define MK_ONE_LAUNCH 1
#endif
constexpr int NWAVES = 8, NTHREADS = 512;
constexpr int DM = 1024, NB = 32, SEQ = 2048, DEPTH = 4, M_TOK = NB * SEQ;
constexpr int INC = 2304, FFH = 2816, NHEAD = 8;
constexpr int N_PHASES = 1 + 5 * DEPTH;
constexpr size_t MiB = 1u << 20;
constexpr size_t WS_WIN = 0;
constexpr size_t WS_WOUT = 18 * MiB;
constexpr size_t WS_WGU = 26 * MiB;
constexpr size_t WS_WDN = 70 * MiB;
constexpr size_t WS_WPW = 92 * MiB;
constexpr size_t WS_SS = 93 * MiB;
constexpr size_t WS_XB = 98 * MiB;
constexpr size_t WS_PROJ = 226 * MiB;
constexpr size_t WS_MIX = 514 * MiB;
constexpr size_t WS_HID = WS_PROJ;
constexpr size_t WS_END = 642 * MiB;
constexpr int LDS_BYTES = 147456;

#define LAS __attribute__((address_space(3)))
typedef unsigned short bf16;
typedef unsigned u32x4 __attribute__((ext_vector_type(4)));
typedef unsigned u32x2 __attribute__((ext_vector_type(2)));
typedef float f32x4 __attribute__((ext_vector_type(4)));
typedef float f32x16 __attribute__((ext_vector_type(16)));
typedef short bf16x8 __attribute__((ext_vector_type(8)));
typedef short s16x4 __attribute__((ext_vector_type(4)));

typedef float f32x2_t __attribute__((ext_vector_type(2))); typedef __bf16 bf16x2_t __attribute__((ext_vector_type(2)));
__device__ __forceinline__ unsigned pk2(float lo, float hi) { const f32x2_t v = {lo, hi}; const bf16x2_t b = __builtin_convertvector(v, bf16x2_t); return __builtin_bit_cast(unsigned, b); }
__device__ __forceinline__ float bflo(unsigned u) { return __builtin_bit_cast(float, u << 16); }
__device__ __forceinline__ float bfhi(unsigned u) { return __builtin_bit_cast(float, u & 0xffff0000u); }
__device__ __forceinline__ float wave_sum(float v) {
#pragma unroll
    for (int o = 1; o < 64; o <<= 1) v += __shfl_xor(v, o);
    return v;
}
__device__ __forceinline__ int tid_opaque() { int t = threadIdx.x; asm volatile("" : "+v"(t)); return t; }
__device__ __forceinline__ int crow(int r, int hi) { return (r & 3) + 8 * (r >> 2) + 4 * hi; }
__device__ __forceinline__ float sigmoidf_(float x) { return __builtin_amdgcn_rcpf(1.0f + __builtin_amdgcn_exp2f(-1.4426950408889634f * x)); }

constexpr int PT_OFF = 147200;
template <class T> __device__ __forceinline__ T* ldp(LAS unsigned char* lds, int k) {
    const unsigned long long v = ((const volatile LAS unsigned long long*)(lds + PT_OFF))[k];
    const unsigned lo = __builtin_amdgcn_readfirstlane((unsigned)v), hi = __builtin_amdgcn_readfirstlane((unsigned)(v >> 32));
    return (T*)(((unsigned long long)hi << 32) | lo);
}
#define PIN(k) ldp<const float>(lds, (k))
struct Args { const float* in[16]; float* out; unsigned char* ws; int ph_lo, ph_hi; };

typedef __attribute__((address_space(1))) unsigned gu32;
#define XB_TMO      128
#define XB_XCNT(j)  (256  + 64 * (j))
#define XB_XSUB(j)  (1280 + 64 * (j))
#define XB_XGEN(j)  (2304 + 64 * (j))
#define XB_TOP      3328
#define XB_TOPGEN   3392
#define XCD_BAR_WORDS 3456
#define XB_SPIN_CAP (1u << 18)

__device__ __forceinline__ unsigned xb_ld(unsigned* p)              { return __hip_atomic_load(p, __ATOMIC_RELAXED, __HIP_MEMORY_SCOPE_AGENT); }
__device__ __forceinline__ unsigned xb_add(unsigned* p, unsigned v) { return __hip_atomic_fetch_add(p, v, __ATOMIC_RELAXED, __HIP_MEMORY_SCOPE_AGENT); }
__device__ __forceinline__ unsigned xb_xcc_id() { return (unsigned)__builtin_amdgcn_s_getreg((3 << 11) | 20) & 0xFu; }
#define XB_SPIN(cond, bar) do { unsigned _sp = 0; while (cond) { __builtin_amdgcn_s_sleep(1); \
    if ((++_sp & 255u) == 0u) { if (xb_ld(&(bar)[XB_TMO])) break; if (_sp > XB_SPIN_CAP) { atomicAdd(&(bar)[XB_TMO], 1u); break; } } } } while (0)

struct XcdBarrier {
    unsigned* bar; unsigned x;
    volatile LAS unsigned* st;
};

__device__ __forceinline__ XcdBarrier xcd_barrier_post(unsigned* bar, volatile LAS unsigned* st) {
    XcdBarrier b; b.bar = bar; b.x = xb_xcc_id(); b.st = st;
    if (threadIdx.x == 0) (void)xb_add(&bar[XB_XCNT(b.x)], 1u);
    return b;
}
__device__ __forceinline__ void xcd_barrier_complete(unsigned* bar, unsigned x, unsigned& nloc, unsigned& nx) {
    const unsigned G = gridDim.x * gridDim.y * gridDim.z;
    unsigned sum, cnt, mine, sp = 0u;
    for (;;) {
        sum = 0u; cnt = 0u; mine = 0u;
#pragma unroll
        for (unsigned j = 0; j < 16; ++j) { const unsigned c = xb_ld(&bar[XB_XCNT(j)]); sum += c; cnt += (c > 0u) ? 1u : 0u; mine = (j == x) ? c : mine; }
        if (sum == G) break;
        __builtin_amdgcn_s_sleep(1);
        if ((++sp & 255u) == 0u) { if (xb_ld(&bar[XB_TMO])) break; if (sp > XB_SPIN_CAP) { atomicAdd(&bar[XB_TMO], 1u); break; } }
    }
    nloc = mine > 0u ? mine : 1u; nx = cnt > 0u ? cnt : 1u;
}

__device__ __forceinline__ void xcd_barrier(const XcdBarrier& b) {
    asm volatile("s_waitcnt vmcnt(0)" ::: "memory");
    __syncthreads();
    if (threadIdx.x == 0) {
        unsigned* bar = b.bar;
        __builtin_amdgcn_s_waitcnt(0);
        unsigned nloc = b.st[0], nx = b.st[1];
        if (nloc == 0u) { xcd_barrier_complete(bar, b.x, nloc, nx); b.st[0] = nloc; b.st[1] = nx; }
        const unsigned old = xb_add(&bar[XB_XSUB(b.x)], 1u);
        const unsigned gen = old / nloc;
        if (old + 1u == (gen + 1u) * nloc) {
            __builtin_amdgcn_fence(__ATOMIC_RELEASE, "agent");
            asm volatile("s_waitcnt vmcnt(0)" ::: "memory");
            const unsigned og = xb_add(&bar[XB_TOP], 1u);
            const unsigned tg = og / nx;
            if (og + 1u == (tg + 1u) * nx) xb_add(&bar[XB_TOPGEN], 1u);
            else XB_SPIN(xb_ld(&bar[XB_TOPGEN]) == tg, bar);
            __builtin_amdgcn_fence(__ATOMIC_ACQUIRE, "agent");
            xb_add(&bar[XB_XGEN(b.x)], 1u);
            asm volatile("s_waitcnt vmcnt(0)" ::: "memory");
        } else {
            XB_SPIN(xb_ld(&bar[XB_XGEN(b.x)]) == gen, bar);
            __builtin_amdgcn_fence(__ATOMIC_ACQUIRE, "agent");
            asm volatile("s_waitcnt vmcnt(0)" ::: "memory");
        }
    }
    __syncthreads();
}

constexpr size_t WS_BAR = 97 * MiB;
constexpr int BST_OFF = PT_OFF + 192;

__device__ __forceinline__ void tr64_fill(const float* W, int N, const float* s, int k0, int srcA, int srcB, LAS float* scr, int lane) {
    const int col4 = (lane & 15) * 4, src = col4 < 32 ? srcA + col4 : srcB + col4 - 32;
    f32x4 v[16];
#pragma unroll
    for (int i = 0; i < 16; ++i) v[i] = *(const f32x4*)(W + (size_t)(k0 + 4 * i + (lane >> 4)) * N + src);
#pragma unroll
    for (int i = 0; i < 16; ++i) { const int kk = 4 * i + (lane >> 4); const float sc = s ? s[k0 + kk] : 1.0f; LAS float* p = scr + kk * 65 + col4;
        p[0] = v[i][0] * sc; p[1] = v[i][1] * sc; p[2] = v[i][2] * sc; p[3] = v[i][3] * sc; }
}
__device__ __forceinline__ void tr64_flush(bf16* WT, int K, int k0, int dstA, int dstB, LAS float* scr, int lane) {
    asm volatile("s_waitcnt lgkmcnt(0)" ::: "memory");
    const int c = lane & 7;
#pragma unroll
    for (int j = 0; j < 8; ++j) { const int n = (lane >> 3) + 8 * j, row = n < 32 ? dstA + n : dstB + n - 32; const LAS float* p = scr + (8 * c) * 65 + n;
        u32x4 o; o.x = pk2(p[0 * 65], p[1 * 65]); o.y = pk2(p[2 * 65], p[3 * 65]); o.z = pk2(p[4 * 65], p[5 * 65]); o.w = pk2(p[6 * 65], p[7 * 65]);
        *(u32x4*)(WT + (size_t)row * K + k0 + 8 * c) = o; }
    asm volatile("s_waitcnt lgkmcnt(0)" ::: "memory");
}
__device__ __forceinline__ void pool_fill(const float* Win, const float* ng, const float* pw, const float* psc, int k0, int g, LAS float* scr, int lane) {
    float pc[64]; const float sc = psc[64 * g + lane];
#pragma unroll
    for (int i = 0; i < 64; ++i) pc[i] = pw[(size_t)(g * 64 + i) * 64 + lane] * sc;
    for (int kb = 0; kb < 64; kb += 4) {
        float wv[4];
#pragma unroll
        for (int q = 0; q < 4; ++q) wv[q] = Win[(size_t)(k0 + kb + q) * INC + 1536 + 64 * g + lane] * ng[k0 + kb + q];
#pragma unroll
        for (int q = 0; q < 4; ++q) { float acc = 0.f;
#pragma unroll
            for (int i = 0; i < 64; ++i) acc += __builtin_bit_cast(float, __builtin_amdgcn_readlane(__builtin_bit_cast(int, wv[q]), i)) * pc[i];
            scr[(kb + q) * 65 + lane] = acc; }
    }
}
__device__ __forceinline__ void p0_prologue(LAS unsigned char* lds, int G, int bid) {
    const int tid = tid_opaque(), lane = tid & 63, wave = __builtin_amdgcn_readfirstlane(tid >> 6);
    LAS float* scr = (LAS float*)(lds + wave * 16640);
    const int gw = bid * NWAVES + wave, NGW = G * NWAVES;
    unsigned char* ws = ldp<unsigned char>(lds, 17);
    constexpr int I_IN = 16 * 36, I_OUT = 16 * 16, I_GU = 16 * 88, I_DN = 44 * 16, I_PW = 4 * 4, I_L = I_IN + I_OUT + I_GU + I_DN + I_PW;
    for (int it = gw; it < DEPTH * I_L; it += NGW) {
        const int l = it / I_L; int r = it % I_L;
        if (r < I_IN) { const int kb = r / 36, nb = r % 36; const int nd = 64 * nb, pn = nd >> 8, bj = (nd >> 7) & 1, h2 = (nd >> 6) & 1;
            bf16* WT = (bf16*)(ws + WS_WIN) + (size_t)l * INC * DM;
            if (pn != 6) { const int sA = pn >= 7 ? 1792 + 256 * bj + 128 * (pn - 7) + 64 * h2 : 256 * pn + 128 * h2 + 32 * bj, sB = pn >= 7 ? sA + 32 : sA + 64;
                tr64_fill(PIN(2) + (size_t)l * DM * INC, INC, PIN(1) + l * DM, 64 * kb, sA, sB, scr, lane); tr64_flush(WT, DM, 64 * kb, nd, nd + 32, scr, lane); }
            else { const int g = nb - 24; pool_fill(PIN(2) + (size_t)l * DM * INC, PIN(1) + l * DM, PIN(5) + (size_t)l * 4 * 64 * 64, PIN(6) + l * 256, 64 * kb, g, scr, lane); tr64_flush(WT, DM, 64 * kb, 1536 + 32 * g, 1536 + 128 + 32 * g, scr, lane); }
            continue; }
        r -= I_IN;
        if (r < I_OUT) { const int kb = r / 16, nd = 64 * (r % 16); tr64_fill(PIN(12) + (size_t)l * DM * DM, DM, nullptr, 64 * kb, nd, nd + 32, scr, lane); tr64_flush((bf16*)(ws + WS_WOUT) + (size_t)l * DM * DM, DM, 64 * kb, nd, nd + 32, scr, lane); continue; }
        r -= I_OUT;
        if (r < I_GU) { const int kb = r / 88, nd = 64 * (r % 88); const int pn = nd >> 8, bj = (nd >> 7) & 1, q2 = (nd >> 6) & 1, src = bj * FFH + 128 * pn + 64 * q2;
            tr64_fill(PIN(14) + (size_t)l * DM * 2 * FFH, 2 * FFH, PIN(13) + l * DM, 64 * kb, src, src + 32, scr, lane); tr64_flush((bf16*)(ws + WS_WGU) + (size_t)l * 2 * FFH * DM, DM, 64 * kb, nd, nd + 32, scr, lane); continue; }
        r -= I_GU;
        if (r < I_DN) { const int kb = r / 16, nd = 64 * (r % 16); tr64_fill(PIN(15) + (size_t)l * FFH * DM, DM, nullptr, 64 * kb, nd, nd + 32, scr, lane); tr64_flush((bf16*)(ws + WS_WDN) + (size_t)l * DM * FFH, FFH, 64 * kb, nd, nd + 32, scr, lane); continue; }
        r -= I_DN;
        { const int kb = r / 4, nd = 64 * (r % 4); tr64_fill(PIN(11) + (size_t)l * 256 * 256, 256, nullptr, 64 * kb, nd, nd + 32, scr, lane); tr64_flush((bf16*)(ws + WS_WPW) + (size_t)l * 256 * 256, 256, 64 * kb, nd, nd + 32, scr, lane); }
    }
    const float* x = PIN(0); bf16* xb = (bf16*)(ws + WS_XB); float* ss = (float*)(ws + WS_SS);
    for (int m = 4 * gw; m < M_TOK; m += 4 * NGW) {
        f32x4 v[4][4]; float s[4];
#pragma unroll
        for (int q = 0; q < 4; ++q)
#pragma unroll
            for (int j = 0; j < 4; ++j) v[q][j] = ((const f32x4*)(x + (size_t)(m + q) * DM) + lane)[64 * j];
#pragma unroll
        for (int q = 0; q < 4; ++q) { s[q] = 0.f;
#pragma unroll
            for (int j = 0; j < 4; ++j) s[q] += (v[q][j][0] * v[q][j][0] + v[q][j][1] * v[q][j][1]) + (v[q][j][2] * v[q][j][2] + v[q][j][3] * v[q][j][3]); }
#pragma unroll
        for (int q = 0; q < 4; ++q) s[q] = wave_sum(s[q]);
#pragma unroll
        for (int q = 0; q < 4; ++q) {
            u32x2* o8 = (u32x2*)(xb + (size_t)(m + q) * DM) + lane;
#pragma unroll
            for (int j = 0; j < 4; ++j) { u32x2 w; w.x = pk2(v[q][j][0], v[q][j][1]); w.y = pk2(v[q][j][2], v[q][j][3]); o8[64 * j] = w; }
            if (lane < 16) ss[(size_t)(m + q) * 16 + lane] = lane == 0 ? s[q] : 0.f; }
    }
}

constexpr int AT_K0 = 0, AT_V0 = 8192, AT_BUF = 16384, AT_FLAGS = 32768;
__device__ __forceinline__ f32x16 at_qk(const LAS unsigned char* kb, const bf16x8 (&qr)[4]) {
    f32x16 s = {};
#pragma unroll
    for (int d0 = 0; d0 < 4; ++d0) { const bf16x8 kf = *(const LAS bf16x8*)(kb + d0 * 2048); s = __builtin_amdgcn_mfma_f32_32x32x16_bf16(kf, qr[d0], s, 0, 0, 0); }
    return s;
}
__device__ __forceinline__ void at_sb(const f32x16& s, bool diag, int r32, int hi, float& carry, u32x4& pa0, u32x4& pa1) {
    float E[16], uu[16], wv[16];
#pragma unroll
    for (int r = 0; r < 16; ++r) { E[r] = __builtin_amdgcn_exp2f(s[r]); uu[r] = 1.0f + E[r]; }
    if (diag) {
#pragma unroll
        for (int r = 0; r < 16; ++r) { const bool valid = crow(r, hi) < r32; uu[r] = valid ? uu[r] : 1.0f; E[r] = valid ? E[r] : 0.0f; }
    }
    float g[4], og[4];
#pragma unroll
    for (int bq = 0; bq < 4; ++bq)
        g[bq] = __builtin_amdgcn_rcpf(((uu[4 * bq + 3] * uu[4 * bq + 2]) * uu[4 * bq + 1]) * uu[4 * bq + 0]);
#pragma unroll
    for (int bq = 0; bq < 4; ++bq) {
        const unsigned own = __builtin_bit_cast(unsigned, g[bq]);
        const auto sw = __builtin_amdgcn_permlane32_swap(own, own, false, false);
        og[bq] = __builtin_bit_cast(float, hi ? sw[0] : sw[1]);
    }
    float pre = carry;
#pragma unroll
    for (int bq = 3; bq >= 0; --bq) {
        const float mine = hi ? pre : pre * og[bq];
        const float i0 = g[bq] * mine, i1 = i0 * uu[4 * bq + 0], i2 = i1 * uu[4 * bq + 1], i3 = i2 * uu[4 * bq + 2];
        wv[4 * bq + 0] = E[4 * bq + 0] * i0; wv[4 * bq + 1] = E[4 * bq + 1] * i1; wv[4 * bq + 2] = E[4 * bq + 2] * i2; wv[4 * bq + 3] = E[4 * bq + 3] * i3;
        pre *= g[bq] * og[bq];
    }
    carry = pre;
    pa0.x = pk2(wv[0], wv[1]); pa0.y = pk2(wv[2], wv[3]); pa0.z = pk2(wv[4], wv[5]); pa0.w = pk2(wv[6], wv[7]);
    pa1.x = pk2(wv[8], wv[9]); pa1.y = pk2(wv[10], wv[11]); pa1.z = pk2(wv[12], wv[13]); pa1.w = pk2(wv[14], wv[15]);
}
__device__ __forceinline__ void at_pv(const LAS unsigned char* vbase, int p, const u32x4& pa0, const u32x4& pa1, f32x16& o0, f32x16& o1) {
#pragma unroll
    for (int sq = 0; sq < 2; ++sq) {
        const bf16x8 pa = __builtin_bit_cast(bf16x8, sq ? pa1 : pa0); const int ks = 2 * p + sq;
#pragma unroll
        for (int d0 = 0; d0 < 2; ++d0) {
            const s16x4 lo = __builtin_bit_cast(s16x4, __builtin_amdgcn_ds_read_tr16_b64_v4i16((LAS s16x4*)(vbase + d0 * 4096 + ks * 1024)));
            const s16x4 hh = __builtin_bit_cast(s16x4, __builtin_amdgcn_ds_read_tr16_b64_v4i16((LAS s16x4*)(vbase + d0 * 4096 + ks * 1024 + 512)));
            const bf16x8 vf = (bf16x8){lo[0], lo[1], lo[2], lo[3], hh[0], hh[1], hh[2], hh[3]};
            if (d0 == 0) o0 = __builtin_amdgcn_mfma_f32_32x32x16_bf16(pa, vf, o0, 0, 0, 0); else o1 = __builtin_amdgcn_mfma_f32_32x32x16_bf16(pa, vf, o1, 0, 0, 0);
        }
    }
}
__device__ __forceinline__ void attn_phase(LAS unsigned char* lds, const bf16* proj, bf16* mix, int G, int bid) {
    const int tid = tid_opaque(), lane = tid & 63, r32 = lane & 31, hi = lane >> 5, wid = __builtin_amdgcn_readfirstlane(tid >> 6);
    bf16x8 qn[4]; u32x4 kn = {}, vn = {};
    if (bid < NB * NHEAD * 8) { const int bh = bid & 255, qb = 7 - (bid >> 8), b = bh >> 3, h = bh & 7; const size_t rowbase = (size_t)b * SEQ; const int nt = 4 * qb + 4;
#pragma unroll
        for (int d0 = 0; d0 < 4; ++d0) qn[d0] = *(const bf16x8*)(proj + (rowbase + qb * 256 + wid * 32 + r32) * INC + h * 64 + d0 * 16 + hi * 8);
        kn = *(const u32x4*)(proj + rowbase * INC + 512 + h * 64 + (size_t)lane * INC + wid * 8 + (size_t)(nt - 1) * 64 * INC);
        vn = *(const u32x4*)(proj + rowbase * INC + 1024 + h * 64 + (size_t)(16 * (wid & 3) + (lane >> 2)) * INC + (wid >> 2) * 32 + (lane & 3) * 8 + (size_t)(nt - 1) * 64 * INC); }
    for (int u = bid; u < NB * NHEAD * 8; u += G) {
        const int bh = u & 255, qb = 7 - (u >> 8), b = bh >> 3, h = bh & 7;
        const size_t rowbase = (size_t)b * SEQ; const int q0 = qb * 256, Q0 = q0 + wid * 32;
        const bf16* Kp = proj + rowbase * INC + 512 + h * 64 + (size_t)lane * INC + wid * 8;
        const bf16* Vp = proj + rowbase * INC + 1024 + h * 64 + (size_t)(16 * (wid & 3) + (lane >> 2)) * INC + (wid >> 2) * 32 + (lane & 3) * 8;
        bf16x8 qr[4];
#pragma unroll
        for (int d0 = 0; d0 < 4; ++d0) qr[d0] = qn[d0];
        const int nt = 4 * qb + 4;
        u32x4 kreg = kn, vreg = vn;
        if (u + G < NB * NHEAD * 8) { const int u2 = u + G, bh2 = u2 & 255, qb2 = 7 - (u2 >> 8), b2 = bh2 >> 3, h2 = bh2 & 7; const size_t rb2 = (size_t)b2 * SEQ; const int nt2 = 4 * qb2 + 4;
#pragma unroll
            for (int d0 = 0; d0 < 4; ++d0) qn[d0] = *(const bf16x8*)(proj + (rb2 + qb2 * 256 + wid * 32 + r32) * INC + h2 * 64 + d0 * 16 + hi * 8);
            kn = *(const u32x4*)(proj + rb2 * INC + 512 + h2 * 64 + (size_t)lane * INC + wid * 8 + (size_t)(nt2 - 1) * 64 * INC);
            vn = *(const u32x4*)(proj + rb2 * INC + 1024 + h2 * 64 + (size_t)(16 * (wid & 3) + (lane >> 2)) * INC + (wid >> 2) * 32 + (lane & 3) * 8 + (size_t)(nt2 - 1) * 64 * INC); }
        __syncthreads();
        *(LAS u32x4*)(lds + AT_K0 + wid * 1024 + lane * 16) = kreg; *(LAS u32x4*)(lds + AT_V0 + wid * 1024 + lane * 16) = vreg;
        kreg = *(const u32x4*)(Kp + (size_t)(nt - 2) * 64 * INC); vreg = *(const u32x4*)(Vp + (size_t)(nt - 2) * 64 * INC);
        float carry = 1.0f; f32x16 o0 = {}, o1 = {};
        int cur = 0;
        for (int j = nt - 1; j >= 0; --j) {
            __syncthreads();
            if (j < nt - 1) {
                const LAS unsigned* fl = (const LAS unsigned*)(lds + AT_FLAGS) + ((j + 1) & 1) * 8;
                const u32x4 f0 = *(const LAS u32x4*)fl, f1 = *(const LAS u32x4*)(fl + 4);
                const unsigned alld = (f0[0] & f0[1] & f0[2] & f0[3]) & (f1[0] & f1[1] & f1[2] & f1[3]);
                if (__builtin_amdgcn_readfirstlane(alld) != 0u) break;
            }
            if (j > 0) { *(LAS u32x4*)(lds + (cur ^ 1) * AT_BUF + AT_K0 + wid * 1024 + lane * 16) = kreg; *(LAS u32x4*)(lds + (cur ^ 1) * AT_BUF + AT_V0 + wid * 1024 + lane * 16) = vreg; }
            if (j > 1) { kreg = *(const u32x4*)(Kp + (size_t)(j - 2) * 64 * INC); vreg = *(const u32x4*)(Vp + (size_t)(j - 2) * 64 * INC); }
            const LAS unsigned char* kbase = lds + cur * AT_BUF + AT_K0 + hi * 1024 + r32 * 16;
            const LAS unsigned char* vbase = lds + cur * AT_BUF + AT_V0 + ((lane >> 4) & 1) * 32 + (lane & 3) * 8 + (4 * hi + ((lane & 15) >> 2)) * 64;
            u32x4 pa0, pa1;
            if (__all(carry == 0.0f)) {   }
            else if (64 * j + 32 < Q0) {
                const f32x16 s1 = at_qk(kbase + 512, qr), s0 = at_qk(kbase, qr);
                at_sb(s1, false, r32, hi, carry, pa0, pa1); at_pv(vbase, 1, pa0, pa1, o0, o1);
                at_sb(s0, false, r32, hi, carry, pa0, pa1); at_pv(vbase, 0, pa0, pa1, o0, o1);
            } else {
#pragma unroll
                for (int pp = 0; pp < 2; ++pp) {
                    const int p = 1 - pp, s0i = 64 * j + 32 * p;
                    if (s0i > Q0) continue;
                    const f32x16 s = at_qk(kbase + p * 512, qr);
                    at_sb(s, s0i == Q0, r32, hi, carry, pa0, pa1); at_pv(vbase, p, pa0, pa1, o0, o1);
                }
            }
            { const unsigned dn = __all(carry == 0.0f) ? 1u : 0u;
              if (lane == 0) ((LAS unsigned*)(lds + AT_FLAGS))[(j & 1) * 8 + wid] = dn; }
            cur ^= 1;
        }
        bf16* Op = mix + (rowbase + Q0) * DM + h * 64 + r32;
#pragma unroll
        for (int r = 0; r < 16; ++r) { bf16* p = Op + (size_t)crow(r, hi) * DM; p[0] = (bf16)(pk2(o0[r], 0.f) & 0xffffu); p[32] = (bf16)(pk2(o1[r], 0.f) & 0xffffu); }
    }
}

__device__ __forceinline__ void unpk8(const u32x4 v, float (&f)[8]) { f[0] = bflo(v.x); f[1] = bfhi(v.x); f[2] = bflo(v.y); f[3] = bfhi(v.y); f[4] = bflo(v.z); f[5] = bfhi(v.z); f[6] = bflo(v.w); f[7] = bfhi(v.w); }
template <int W> __device__ __forceinline__ void pool_item(const bf16* proj, bf16* mix, int tok0, int c) {
    const int t0 = tok0 & (SEQ - 1);
    u32x4 raw[W + 3];
#pragma unroll
    for (int r = 0; r < W + 3; ++r) { const int dt = r - (W - 1); raw[r] = (u32x4){0u, 0u, 0u, 0u}; if (t0 + dt >= 0) raw[r] = *(const u32x4*)(proj + (size_t)(tok0 + dt) * INC + 1536 + c); }
    float s[8], f[8];
#pragma unroll
    for (int k = 0; k < 8; ++k) s[k] = 0.f;
#pragma unroll
    for (int r = 0; r < W; ++r) { unpk8(raw[r], f);
#pragma unroll
        for (int k = 0; k < 8; ++k) s[k] += f[k]; }
#pragma unroll
    for (int i = 0; i < 4; ++i) {
        float m0[8]; unpk8(raw[W - 1 + i], m0);
        if (i > 0) { unpk8(raw[i - 1], f);
#pragma unroll
            for (int k = 0; k < 8; ++k) s[k] += m0[k] - f[k]; }
        const int cnt = (t0 + i + 1) < W ? (t0 + i + 1) : W; const float inv = 1.0f / (float)cnt;
        u32x4 o; o.x = pk2(s[0] * inv - m0[0], s[1] * inv - m0[1]); o.y = pk2(s[2] * inv - m0[2], s[3] * inv - m0[3]); o.z = pk2(s[4] * inv - m0[4], s[5] * inv - m0[5]); o.w = pk2(s[6] * inv - m0[6], s[7] * inv - m0[7]);
        *(u32x4*)(mix + (size_t)(tok0 + i) * DM + 512 + c) = o;
    }
}
__device__ __forceinline__ void pool_phase(const bf16* proj, bf16* mix, int G, int bid) {
    const int tid = tid_opaque(), lane = tid & 63, wave = tid >> 6;
    for (int wi = bid * NWAVES + wave; wi < 4 * (M_TOK / 32); wi += G * NWAVES) {
        const int g = (wi + (wi >> 11)) & 3, tok0 = ((wi >> 2) * 8 + (lane >> 3)) * 4, c = 64 * g + 8 * (lane & 7);
        if (g == 0) pool_item<2>(proj, mix, tok0, c); else if (g == 1) pool_item<4>(proj, mix, tok0, c); else if (g == 2) pool_item<8>(proj, mix, tok0, c); else pool_item<16>(proj, mix, tok0, c);
    }
}

constexpr int CV_ROWS = 94, CV_AB = CV_ROWS * 256 * 4  , CV_APITCH = 528;
__device__ __forceinline__ void conv_phase(LAS unsigned char* lds, const bf16* proj, bf16* mix, const float* cw, const float* cb, const float* lng, const float* lnb, const bf16* pwT, int G, int bid) {
    LAS float* hb = (LAS float*)lds; LAS unsigned char* ab = lds + CV_AB;
    const int tid = tid_opaque(), lane = tid & 63, r32 = lane & 31, hi = lane >> 5, wid = __builtin_amdgcn_readfirstlane(tid >> 6);
    const int c = tid & 255, half = tid >> 8;
    if (bid >= M_TOK / 64) return;
    bf16x8 pwf[16];
#pragma unroll
    for (int kk = 0; kk < 16; ++kk) pwf[kk] = *(const bf16x8*)(pwT + (size_t)(32 * wid + r32) * 256 + 16 * kk + 8 * hi);
    float w[31];
#pragma unroll
    for (int j = 0; j < 31; ++j) w[j] = cw[j * 256 + c];
    const float bias = cb[c];
    const f32x4 gg = *(const f32x4*)(lng + 4 * lane), bb = *(const f32x4*)(lnb + 4 * lane);
    for (int tile = bid; tile < M_TOK / 64; tile += G) {
        const int tok0 = tile * 64, t0 = tok0 & (SEQ - 1);
        u32x4 av[6];
#pragma unroll
        for (int k = 0; k < 6; ++k) { const int it = tid + NTHREADS * k, i = it >> 5, c8 = (it & 31) * 8; av[k] = (u32x4){0u, 0u, 0u, 0u};
            if (it < CV_ROWS * 32 && t0 - 30 + i >= 0) av[k] = *(const u32x4*)(proj + (size_t)(tok0 - 30 + i) * INC + 1792 + c8); }
        __syncthreads();
#pragma unroll
        for (int k = 0; k < 6; ++k) { const int it = tid + NTHREADS * k, i = it >> 5, c8 = (it & 31) * 8;
            if (it < CV_ROWS * 32) { float a8[8]; unpk8(av[k], a8);
                *(LAS f32x4*)(hb + i * 256 + c8) = (f32x4){a8[0], a8[1], a8[2], a8[3]}; *(LAS f32x4*)(hb + i * 256 + c8 + 4) = (f32x4){a8[4], a8[5], a8[6], a8[7]}; } }
        __syncthreads();
        float in[62];
#pragma unroll
        for (int i = 0; i < 62; ++i) in[i] = hb[(32 * half + i) * 256 + c];
        __syncthreads();
#pragma unroll
        for (int t = 0; t < 32; ++t) { float acc = bias;
#pragma unroll
            for (int j = 0; j < 31; ++j) acc += w[j] * in[t + j];
            hb[(32 * half + t) * 256 + c] = acc; }
        __syncthreads();
#pragma unroll
        for (int tt = 0; tt < 8; ++tt) { const int tk = 8 * wid + tt; const f32x4 v = *(const LAS f32x4*)(hb + tk * 256 + 4 * lane);
            const float mean = wave_sum((v[0] + v[1]) + (v[2] + v[3])) * (1.0f / 256.0f); const f32x4 d = v - mean;
            const float var = wave_sum((d[0] * d[0] + d[1] * d[1]) + (d[2] * d[2] + d[3] * d[3])) * (1.0f / 256.0f); const float rstd = 1.0f / sqrtf(var + 1e-5f);
            f32x4 y = d * rstd * gg + bb;
#pragma unroll
            for (int i = 0; i < 4; ++i) y[i] = y[i] * sigmoidf_(y[i]);
            u32x2 o; o.x = pk2(y[0], y[1]); o.y = pk2(y[2], y[3]); *(LAS u32x2*)(ab + tk * CV_APITCH + lane * 8) = o; }
        __syncthreads();
        f32x16 a0 = {}, a1 = {};
#pragma unroll
        for (int kk = 0; kk < 16; ++kk) {
            const bf16x8 f0 = *(const LAS bf16x8*)(ab + r32 * CV_APITCH + (16 * kk + 8 * hi) * 2), f1 = *(const LAS bf16x8*)(ab + (r32 + 32) * CV_APITCH + (16 * kk + 8 * hi) * 2);
            a0 = __builtin_amdgcn_mfma_f32_32x32x16_bf16(f0, pwf[kk], a0, 0, 0, 0); a1 = __builtin_amdgcn_mfma_f32_32x32x16_bf16(f1, pwf[kk], a1, 0, 0, 0);
        }
        bf16* Op = mix + (size_t)tok0 * DM + 768 + 32 * wid + r32;
#pragma unroll
        for (int r = 0; r < 16; ++r) { Op[(size_t)crow(r, hi) * DM] = (bf16)(pk2(a0[r], 0.f) & 0xffffu); Op[(size_t)(crow(r, hi) + 32) * DM] = (bf16)(pk2(a1[r], 0.f) & 0xffffu); }
    }
}

__global__ void __launch_bounds__(NTHREADS, 2) mk_fwd(Args a) {
    extern __shared__ __attribute__((aligned(16))) unsigned char lds_raw[];
    LAS unsigned char* lds = (LAS unsigned char*)lds_raw;
    const int G = gridDim.x, bid = blockIdx.x;
    if (threadIdx.x == 0) { LAS unsigned long long* PT = (LAS unsigned long long*)(lds + PT_OFF);
        PT[0] = (unsigned long long)a.in[0]; PT[1] = (unsigned long long)a.in[1]; PT[2] = (unsigned long long)a.in[2]; PT[3] = (unsigned long long)a.in[3];
        PT[4] = (unsigned long long)a.in[4]; PT[5] = (unsigned long long)a.in[5]; PT[6] = (unsigned long long)a.in[6]; PT[7] = (unsigned long long)a.in[7];
        PT[8] = (unsigned long long)a.in[8]; PT[9] = (unsigned long long)a.in[9]; PT[10] = (unsigned long long)a.in[10]; PT[11] = (unsigned long long)a.in[11];
        PT[12] = (unsigned long long)a.in[12]; PT[13] = (unsigned long long)a.in[13]; PT[14] = (unsigned long long)a.in[14]; PT[15] = (unsigned long long)a.in[15];
        PT[16] = (unsigned long long)a.out; PT[17] = (unsigned long long)a.ws; }
    if (threadIdx.x == 0) { ((volatile LAS unsigned*)(lds + BST_OFF))[0] = 0u; ((volatile LAS unsigned*)(lds + BST_OFF))[1] = 0u; }
    const int ph_hi = a.ph_hi;
    __syncthreads();
    if (MK_ONE_LAUNCH) (void)xcd_barrier_post((unsigned*)(a.ws + WS_BAR), (volatile LAS unsigned*)(lds + BST_OFF));
    for (int ph = a.ph_lo; ph < ph_hi; ++ph) {
        if (ph == 0) {
            p0_prologue(lds, G, bid);
        }
        else {
            const int l = (ph - 1) / 5, sp = (ph - 1) % 5;
            unsigned char* ws = ldp<unsigned char>(lds, 17);
            bf16* xb = (bf16*)(ws + WS_XB); float* ss = (float*)(ws + WS_SS); bf16* proj = (bf16*)(ws + WS_PROJ); bf16* mix = (bf16*)(ws + WS_MIX); bf16* hid = (bf16*)(ws + WS_HID);
            if (sp == 1) {
                attn_phase(lds, proj, mix, G, bid);
                asm volatile("" ::: "memory");
                pool_phase(proj, mix, G, bid);
                asm volatile("" ::: "memory");
                conv_phase(lds, proj, mix, PIN(7) + l * 31 * 256, PIN(8) + l * 256, PIN(9) + l * 256, PIN(10) + l * 256, (const bf16*)(ws + WS_WPW) + (size_t)l * 256 * 256, G, bid);
            } else {
                pg8::Gemm g; pg8::EpiAny E; float* outp = ldp<float>(lds, 16);
                E.ss_in = ss; E.ss_out = ss; E.out = outp; E.qg = PIN(3) + l * 64; E.kg = PIN(4) + l * 64;
                if (sp == 0)      { g = pg8::Gemm{xb, (const bf16*)(ws + WS_WIN) + (size_t)l * INC * DM, M_TOK, INC, DM}; E.kind = 0; E.ob = proj; }
                else if (sp == 2) { g = pg8::Gemm{mix, (const bf16*)(ws + WS_WOUT) + (size_t)l * DM * DM, M_TOK, DM, DM}; E.kind = 1; E.ob = xb; }
                else if (sp == 3) { g = pg8::Gemm{xb, (const bf16*)(ws + WS_WGU) + (size_t)l * 2 * FFH * DM, M_TOK, 2 * FFH, DM}; E.kind = 2; E.ob = hid; }
                else              { g = pg8::Gemm{hid, (const bf16*)(ws + WS_WDN) + (size_t)l * DM * FFH, M_TOK, DM, FFH}; E.kind = (l == DEPTH - 1) ? 6 : 1; E.ob = xb; }
                pg8::StaticOrder S; S.init(g.M, g.N, G, bid);
                asm volatile("" ::: "memory");
                pg8::gemm_phase<pg8::EpiAny, pg8::StaticOrder, true, true>(lds, g, S, E);
            }
        }
        if (ph + 1 < ph_hi) { {
            if (ph == 0) cg::this_grid().sync();
            else { XcdBarrier xb; xb.bar = (unsigned*)(ldp<unsigned char>(lds, 17) + WS_BAR); xb.x = xb_xcc_id(); xb.st = (volatile LAS unsigned*)(lds + BST_OFF); xcd_barrier(xb); } } }
    }
}

extern "C" void kernel_launch(void* const* d_in, const int* in_sizes, int n_in, void* d_out, int out_size, void* d_ws, size_t ws_size, hipStream_t stream) {
    static int grid = 0;
    if (grid == 0) {
        if (n_in != 16 || in_sizes[0] != M_TOK * DM || out_size != M_TOK * DM || ws_size < WS_END) { fprintf(stderr, "kernel_launch: unexpected shapes (n_in %d, in0 %d, out %d, ws %zu)\n", n_in, n_in > 0 ? in_sizes[0] : -1, out_size, ws_size); grid = -1; return; }
        int dev = 0, cus = 0, per_cu = 0;
        if (hipGetDevice(&dev) != hipSuccess || hipDeviceGetAttribute(&cus, hipDeviceAttributeMultiprocessorCount, dev) != hipSuccess) { grid = -1; return; }
        if (hipFuncSetAttribute((const void*)mk_fwd, hipFuncAttributeMaxDynamicSharedMemorySize, LDS_BYTES) != hipSuccess) { fprintf(stderr, "kernel_launch: hipFuncSetAttribute failed\n"); grid = -1; return; }
        if (hipOccupancyMaxActiveBlocksPerMultiprocessor(&per_cu, (const void*)mk_fwd, NTHREADS, LDS_BYTES) != hipSuccess || per_cu < 1) { fprintf(stderr, "kernel_launch: occupancy query says %d\n", per_cu); per_cu = 1; }
        (void)hipGetLastError();
        grid = cus * per_cu;
    }
    if (grid < 0) return;
    if (MK_ONE_LAUNCH) { if (hipMemsetAsync((char*)d_ws + WS_BAR, 0, 16384, stream) != hipSuccess) { fprintf(stderr, "kernel_launch: memset failed\n"); return; } }
    Args a{};
    for (int i = 0; i < 16; ++i) a.in[i] = (const float*)d_in[i];
    a.out = (float*)d_out; a.ws = (unsigned char*)d_ws;
#if MK_ONE_LAUNCH
    a.ph_lo = 0; a.ph_hi = N_PHASES;
    void* args[] = {&a};
    hipError_t e = hipLaunchCooperativeKernel((const void*)mk_fwd, dim3(grid), dim3(NTHREADS), args, LDS_BYTES, stream);
    if (e != hipSuccess) fprintf(stderr, "kernel_launch: cooperative launch failed: %s (grid %d)\n", hipGetErrorString(e), grid);
#else
    for (int ph = 0; ph < N_PHASES; ++ph) { a.ph_lo = ph; a.ph_hi = ph + 1; hipLaunchKernelGGL(mk_fwd, dim3(grid), dim3(NTHREADS), LDS_BYTES, stream, a); }
#endif
}
```

```cpp
#define MK_ONE_LAUNCH 1
#include <hip/hip_runtime.h>
#include <hip/hip_cooperative_groups.h>
#include <cstdio>
#include <cstdint>
namespace cg = cooperative_groups;
namespace pg8 {
#define PG8_LAS __attribute__((address_space(3)))
typedef unsigned short bf16_t;
typedef short bf16x8 __attribute__((ext_vector_type(8)));
typedef float f32x4 __attribute__((ext_vector_type(4)));
typedef unsigned u32x4 __attribute__((ext_vector_type(4)));
constexpr int BM = 256, BK = 64, HALF = 128, HTB = HALF * BK * 2  , STAGE_BYTES = 8 * HTB, NXCD = 8, WGM = 8;

__host__ __device__ __forceinline__ int lds_byte(int r, int c) { const int st = (r >> 4) * 2 + (c >> 5), rr = r & 15, cc = c & 31, ob = rr * 64 + cc * 2; return st * 1024 + (ob ^ (((ob >> 9) & 1) << 5)); }
__host__ __device__ __forceinline__ void stage_rc(int b, int& R, int& C) { const int st = b / 1024, sb = b % 1024, swz = sb ^ (((sb >> 9) & 1) << 5); R = (st >> 1) * 16 + swz / 64; C = (st & 1) * 32 + (swz % 64) / 2; }
__host__ __device__ __forceinline__ int perm32(int rho) { const int n = rho >> 4, i = rho & 15; return 8 * (i >> 2) + 4 * n + (i & 3); }

struct Unit { int pm, pn; };
struct Gemm { const bf16_t* A; const bf16_t* Bt; int M, N, K; };

struct StaticOrder {
    int nM, nN, nwg, G, c;
    __host__ __device__ void init(int M, int N, int G_, int c_) { nM = M / BM; nN = N / BM; nwg = nM * nN; G = G_; c = c_; }
    __host__ __device__ bool next(int i, Unit& u) const {
        const long L = (long)i * G + c; if (L >= nwg) return false;
        int wgid = (int)L; { const int q = nwg / NXCD, r = nwg % NXCD, xcd = wgid % NXCD, off = wgid / NXCD; wgid = (xcd < r ? xcd * (q + 1) : r * (q + 1) + (xcd - r) * q) + off; }
        const int nig = WGM * nN, gid = wgid / nig, fm = gid * WGM, gsz = (nM - fm) < WGM ? (nM - fm) : WGM;
        u.pm = fm + ((wgid % nig) % gsz); u.pn = (wgid % nig) / gsz; return true;
    }
    __device__ __forceinline__ void a_ready(const Unit&) const {}
    __device__ __forceinline__ void done(const Unit&) const {}
};
typedef float f32x2 __attribute__((ext_vector_type(2))); typedef __bf16 pg8_bf16x2 __attribute__((ext_vector_type(2)));
__device__ __forceinline__ unsigned cvt_pk_bf16(float lo, float hi) { const f32x2 v = {lo, hi}; const pg8_bf16x2 b = __builtin_convertvector(v, pg8_bf16x2); return __builtin_bit_cast(unsigned, b); }
typedef unsigned u32x4 __attribute__((ext_vector_type(4)));
__device__ __forceinline__ void row_rstd(const float* ss, int row0, int fq, float (&rs)[2][4]) {
#pragma unroll
    for (int ai = 0; ai < 2; ++ai)
#pragma unroll
        for (int m = 0; m < 4; ++m) {
            const f32x4 v = *(const f32x4*)(ss + (size_t)(row0 + ai * HALF + m * 16) * 16 + 4 * fq);
            float s = (v[0] + v[1]) + (v[2] + v[3]);
            s += __shfl_xor(s, 16); s += __shfl_xor(s, 32);
            rs[ai][m] = __builtin_amdgcn_rsqf(s * (1.0f / 1024.0f) + 1e-6f)    ;
        }
}
struct EpiInProj {
    static constexpr bool PERM = true, AFTER_DRAIN = false;
    bf16_t* P; const float* ss; const float* qg; const float* kg;
    __device__ __forceinline__ void operator()(const f32x4 (&acc)[2][2][4][2], const Unit& u, int wr, int wc, int fr, int fq) const {
        const int row0 = u.pm * BM + wr * 64 + fr;
        float rs[2][4]; row_rstd(ss, row0, fq, rs);
        if (u.pn >= 7) {
#pragma unroll
            for (int ai = 0; ai < 2; ++ai)
#pragma unroll
                for (int m = 0; m < 4; ++m) { const float r = rs[ai][m]; f32x4 h[2];
#pragma unroll
                    for (int n = 0; n < 2; ++n) { const f32x4 a = acc[ai][0][m][n] * r, gt = acc[ai][1][m][n] * r;
#pragma unroll
                        for (int i = 0; i < 4; ++i) h[n][i] = a[i] * __builtin_amdgcn_rcpf(1.0f + __builtin_amdgcn_exp2f(-1.4426950408889634f * gt[i])); }
                    u32x4 w; w.x = cvt_pk_bf16(h[0][0], h[0][1]); w.y = cvt_pk_bf16(h[0][2], h[0][3]); w.z = cvt_pk_bf16(h[1][0], h[1][1]); w.w = cvt_pk_bf16(h[1][2], h[1][3]);
                    *(u32x4*)(P + (size_t)(row0 + ai * HALF + m * 16) * 2304 + 1792 + 128 * (u.pn - 7) + 32 * wc + 8 * fq) = w; }
            return;
        }
        const bool isq = u.pn < 2, isk = (u.pn >= 2 && u.pn < 4), hn = isq || isk;
        f32x4 gv[2][2];
#pragma unroll
        for (int bj = 0; bj < 2; ++bj)
#pragma unroll
            for (int n = 0; n < 2; ++n) gv[bj][n] = (f32x4){1.f, 1.f, 1.f, 1.f};
        if (hn) { const float* g = isq ? qg : kg; const float sc = isq ? 0.125f * 1.4426950408889634f : 1.0f;
#pragma unroll
            for (int bj = 0; bj < 2; ++bj)
#pragma unroll
                for (int n = 0; n < 2; ++n) gv[bj][n] = *(const f32x4*)(g + 32 * bj + 8 * fq + 4 * n) * sc; }
#pragma unroll
        for (int ai = 0; ai < 2; ++ai)
#pragma unroll
            for (int m = 0; m < 4; ++m) {
                const float r = rs[ai][m];
                f32x4 v[2][2];
#pragma unroll
                for (int bj = 0; bj < 2; ++bj)
#pragma unroll
                    for (int n = 0; n < 2; ++n) v[bj][n] = acc[ai][bj][m][n] * r;
                if (hn) {
                    float q = 0.f;
#pragma unroll
                    for (int bj = 0; bj < 2; ++bj)
#pragma unroll
                        for (int n = 0; n < 2; ++n) { const f32x4 x = v[bj][n]; q += (x[0] * x[0] + x[1] * x[1]) + (x[2] * x[2] + x[3] * x[3]); }
                    q += __shfl_xor(q, 16); q += __shfl_xor(q, 32);
                    const float hr = __builtin_amdgcn_rsqf(q * (1.0f / 64.0f) + 1e-6f);
#pragma unroll
                    for (int bj = 0; bj < 2; ++bj)
#pragma unroll
                        for (int n = 0; n < 2; ++n) v[bj][n] = v[bj][n] * hr * gv[bj][n];
                }
                bf16_t* rowp = P + (size_t)(row0 + ai * HALF + m * 16) * 2304 + u.pn * BM + 64 * wc + 8 * fq;
#pragma unroll
                for (int bj = 0; bj < 2; ++bj) { u32x4 w; w.x = cvt_pk_bf16(v[bj][0][0], v[bj][0][1]); w.y = cvt_pk_bf16(v[bj][0][2], v[bj][0][3]); w.z = cvt_pk_bf16(v[bj][1][0], v[bj][1][1]); w.w = cvt_pk_bf16(v[bj][1][2], v[bj][1][3]);
                    *(u32x4*)(rowp + 32 * bj) = w; }
            }
    }
};
__device__ __forceinline__ float u2f(unsigned u) { return __builtin_bit_cast(float, u); }
__device__ __forceinline__ float bf_lo_f(unsigned u) { return __builtin_bit_cast(float, u << 16); }
__device__ __forceinline__ float bf_hi_f(unsigned u) { return __builtin_bit_cast(float, u & 0xffff0000u); }
template <bool IN32, bool OUT32> struct EpiResT {
    static constexpr bool PERM = true, AFTER_DRAIN = false;
    float* out; bf16_t* xb; float* ss;
    __device__ __forceinline__ void operator()(const f32x4 (&acc)[2][2][4][2], const Unit& u, int wr, int wc, int fr, int fq) const {
        const int row0 = u.pm * BM + wr * 64 + fr; const int colb = u.pn * BM + wc * 32 + 8 * fq;
#pragma unroll
        for (int am = 0; am < 4; ++am) { const int ai = am >> 1, mb = (am & 1) * 2;
            u32x4 bv[2][2][2];
#pragma unroll
            for (int mm = 0; mm < 2; ++mm)
#pragma unroll
                for (int bj = 0; bj < 2; ++bj) { const size_t off = (size_t)(row0 + ai * HALF + (mb + mm) * 16) * 1024 + colb + bj * HALF;
                    bv[mm][bj][0] = *(const u32x4*)(xb + off); bv[mm][bj][1] = bv[mm][bj][0]; }
            asm volatile("" ::: "memory");
#pragma unroll
            for (int mm = 0; mm < 2; ++mm) { const int m = mb + mm;
                const int row = row0 + ai * HALF + m * 16; float q = 0.f;
#pragma unroll
                for (int bj = 0; bj < 2; ++bj) {
                    const size_t off = (size_t)row * 1024 + colb + bj * HALF;
                    float x[8];
                    {
#pragma unroll
                        for (int k = 0; k < 4; ++k) { x[2 * k] = bf_lo_f(bv[mm][bj][0][k]); x[2 * k + 1] = bf_hi_f(bv[mm][bj][0][k]); }
                    }
#pragma unroll
                    for (int k = 0; k < 4; ++k) { x[k] += acc[ai][bj][m][0][k]; x[4 + k] += acc[ai][bj][m][1][k]; }
                    if (OUT32) { *(f32x4*)(out + off) = (f32x4){x[0], x[1], x[2], x[3]}; *(f32x4*)(out + off + 4) = (f32x4){x[4], x[5], x[6], x[7]}; }
                    else {
                        u32x4 h;
#pragma unroll
                        for (int k = 0; k < 4; ++k) h[k] = cvt_pk_bf16(x[2 * k], x[2 * k + 1]);
                        *(u32x4*)(xb + off) = h;
#pragma unroll
                        for (int k = 0; k < 8; ++k) q += x[k] * x[k];
                    }
                }
                if (!OUT32) { q += __shfl_xor(q, 16); q += __shfl_xor(q, 32); if (fq == 0) ss[(size_t)row * 16 + 4 * u.pn + wc] = q; }
            }
            asm volatile("" ::: "memory");
        }
    }
};
struct EpiGU {
    static constexpr bool PERM = true, AFTER_DRAIN = false;
    bf16_t* H; const float* ss;
    __device__ __forceinline__ void operator()(const f32x4 (&acc)[2][2][4][2], const Unit& u, int wr, int wc, int fr, int fq) const {
        const int row0 = u.pm * BM + wr * 64 + fr;
        float rs[2][4]; row_rstd(ss, row0, fq, rs);
#pragma unroll
        for (int ai = 0; ai < 2; ++ai)
#pragma unroll
            for (int m = 0; m < 4; ++m) {
                const float r = rs[ai][m]; f32x4 h[2];
#pragma unroll
                for (int n = 0; n < 2; ++n) { const f32x4 g = acc[ai][0][m][n] * r, up = acc[ai][1][m][n] * r;
#pragma unroll
                    for (int i = 0; i < 4; ++i) h[n][i] = g[i] * up[i] * __builtin_amdgcn_rcpf(1.0f + __builtin_amdgcn_exp2f(-1.4426950408889634f * g[i])); }
                u32x4 w; w.x = cvt_pk_bf16(h[0][0], h[0][1]); w.y = cvt_pk_bf16(h[0][2], h[0][3]); w.z = cvt_pk_bf16(h[1][0], h[1][1]); w.w = cvt_pk_bf16(h[1][2], h[1][3]);
                *(u32x4*)(H + (size_t)(row0 + ai * HALF + m * 16) * 2816 + u.pn * HALF + wc * 32 + 8 * fq) = w;
            }
    }
};

struct EpiAny {
    static constexpr bool PERM = true, AFTER_DRAIN = false;
    int kind; bf16_t* ob; const float* ss_in; float* ss_out; float* out; const float* qg; const float* kg;
    __device__ __forceinline__ void operator()(const f32x4 (&acc)[2][2][4][2], const Unit& u, int wr, int wc, int fr, int fq) const {
        if (kind == 0) { EpiInProj e{ob, ss_in, qg, kg}; e(acc, u, wr, wc, fr, fq); }
        else if (kind == 1) { EpiResT<false, false> e{out, ob, ss_out}; e(acc, u, wr, wc, fr, fq); }
        else if (kind == 6) { EpiResT<false, true> e{out, ob, ss_out}; e(acc, u, wr, wc, fr, fq); }
        else { EpiGU e{ob, ss_in}; e(acc, u, wr, wc, fr, fq); }
    }
};
template <class Epi, class Sched, bool ALIGN_EPI = false, bool SP2 = false>
__device__ __forceinline__ void gemm_phase(PG8_LAS unsigned char* lds, const Gemm g, const Sched& S, const Epi& E) {
    int tid_ = threadIdx.x; asm volatile("" : "+v"(tid_)); const int tid = tid_, wid = __builtin_amdgcn_readfirstlane(tid >> 6), lane = tid & 63, wr = wid >> 2, wc = wid & 3, fr = lane & 15, fq = lane >> 4;
    const int K = g.K, nt = K / BK;
    unsigned voffA[2], voffB[2];
#pragma unroll
    for (int i = 0; i < 2; ++i) { int R, C; stage_rc(tid * 16 + i * 8192, R, C); const int Rb = Epi::PERM ? ((R & ~31) + perm32(R & 31)) : R;
        voffA[i] = (unsigned)(R * K + C) * 2u; voffB[i] = (unsigned)(Rb * K + C) * 2u; }
    const size_t kstep = (size_t)(BK * 2);
    const size_t hstep = (size_t)HALF * K * 2;
    const size_t tstep = 2 * hstep;
    const unsigned ldsw = (unsigned)wid * 1024u;
    const int aoff = lds_byte(wr * 64 + fr, fq * 8), boff = lds_byte(wc * 32 + fr, fq * 8);
#define PG8_SA(b, h) (((b) * 2 + (h)) * HTB)
#define PG8_SB(b, h) ((4 + (b) * 2 + (h)) * HTB)
#define PG8_STAGE(bufoff, gbase, voff) do { _Pragma("unroll") for (int _i = 0; _i < 2; ++_i) \
        __builtin_amdgcn_global_load_lds((const unsigned*)((const char*)(gbase) + (voff)[_i]), (PG8_LAS unsigned*)(lds + (bufoff) + ldsw + _i * 8192), 16, 0, 0); } while (0)
#define PG8_LDA(dst, b, h) do { _Pragma("unroll") for (int m = 0; m < 4; ++m) _Pragma("unroll") for (int k = 0; k < 2; ++k) dst[m][k] = *(const PG8_LAS bf16x8*)(lds + PG8_SA(b, h) + aoff + m * 2048 + k * 1024); } while (0)
#define PG8_LDB(dst, b, h) do { _Pragma("unroll") for (int n = 0; n < 2; ++n) _Pragma("unroll") for (int k = 0; k < 2; ++k) dst[n][k] = *(const PG8_LAS bf16x8*)(lds + PG8_SB(b, h) + boff + n * 2048 + k * 1024); } while (0)
#define PG8_MMA(ai, bj, At, Bt) do { __builtin_amdgcn_s_setprio(1); _Pragma("unroll") for (int m = 0; m < 4; ++m) _Pragma("unroll") for (int n = 0; n < 2; ++n) _Pragma("unroll") for (int k = 0; k < 2; ++k) \
        acc[ai][bj][m][n] = __builtin_amdgcn_mfma_f32_16x16x32_bf16(Bt[n][k], At[m][k], acc[ai][bj][m][n], 0, 0, 0); __builtin_amdgcn_s_setprio(0); } while (0)
#define PG8_WAIT_V(n) asm volatile("s_waitcnt vmcnt(" #n ")" ::: "memory")
#define PG8_WAIT_L(n) asm volatile("s_waitcnt lgkmcnt(" #n ")" ::: "memory")
#define PG8_BAR __builtin_amdgcn_s_barrier()
#define PG8_SCHED __builtin_amdgcn_sched_barrier(0)
    Unit cur, nxt; int ui = 0;
    if (!S.next(0, cur)) return;
    f32x4 acc[2][2][4][2];
#pragma unroll
    for (int a = 0; a < 2; ++a)
#pragma unroll
        for (int b = 0; b < 2; ++b)
#pragma unroll
            for (int m = 0; m < 4; ++m)
#pragma unroll
                for (int n = 0; n < 2; ++n) acc[a][b][m][n] = (f32x4){0.f, 0.f, 0.f, 0.f};
    bf16x8 At[4][2], B0[2][2], B1[2][2];
    const char* cA = (const char*)g.A + (size_t)cur.pm * tstep; const char* cB = (const char*)g.Bt + (size_t)cur.pn * tstep;
    S.a_ready(cur);
    if constexpr (SP2) {
        PG8_STAGE(PG8_SB(0, 0), cB, voffB); PG8_STAGE(PG8_SB(0, 1), cB + hstep, voffB); PG8_STAGE(PG8_SA(0, 0), cA, voffA); PG8_STAGE(PG8_SA(0, 1), cA + hstep, voffA);
        if (wr == 1) PG8_BAR;
        PG8_WAIT_V(2); PG8_BAR;
        PG8_STAGE(PG8_SB(1, 0), cB + kstep, voffB); PG8_STAGE(PG8_SA(1, 0), cA + kstep, voffA); PG8_STAGE(PG8_SB(1, 1), cB + hstep + kstep, voffB);
        PG8_WAIT_V(6); PG8_BAR;
    } else {
        PG8_STAGE(PG8_SB(0, 0), cB, voffB); PG8_STAGE(PG8_SA(0, 0), cA, voffA); PG8_STAGE(PG8_SB(0, 1), cB + hstep, voffB); PG8_STAGE(PG8_SA(0, 1), cA + hstep, voffA);
        if (wr == 1) PG8_BAR;
        PG8_WAIT_V(4); PG8_BAR;
        PG8_STAGE(PG8_SB(1, 0), cB + kstep, voffB); PG8_STAGE(PG8_SA(1, 0), cA + kstep, voffA); PG8_STAGE(PG8_SB(1, 1), cB + hstep + kstep, voffB);
        PG8_WAIT_V(6); PG8_BAR;
    }
    for (;;) {
        const bool has_next = S.next(ui + 1, nxt);
        const char* nA = has_next ? (const char*)g.A + (size_t)nxt.pm * tstep : cA; const char* nB = has_next ? (const char*)g.Bt + (size_t)nxt.pn * tstep : cB;
        for (int t = 0; t < nt; t += 2) {
            const bool last = (t == nt - 2);
            const char* a1 = cA + (size_t)(t + 1) * kstep;
            const char* a2 = last ? nA : cA + (size_t)(t + 2) * kstep; const char* b2 = last ? nB : cB + (size_t)(t + 2) * kstep;
            const char* a3 = a2 + kstep; const char* b3 = b2 + kstep;
            if (last && has_next) S.a_ready(nxt);
            if constexpr (SP2) {
            PG8_LDB(B0, 0, 0); PG8_LDB(B1, 0, 1); PG8_SCHED; PG8_LDA(At, 0, 0); PG8_STAGE(PG8_SA(1, 1), a1 + hstep, voffA);
            PG8_WAIT_V(8); PG8_WAIT_L(0); PG8_BAR; PG8_MMA(0, 0, At, B0); PG8_MMA(0, 1, At, B1); PG8_BAR; PG8_SCHED;
            PG8_LDA(At, 0, 1); PG8_STAGE(PG8_SB(0, 0), b2, voffB); PG8_STAGE(PG8_SB(0, 1), b2 + hstep, voffB); PG8_STAGE(PG8_SA(0, 0), a2, voffA);
            PG8_WAIT_V(8); PG8_WAIT_L(0); PG8_BAR; PG8_MMA(1, 0, At, B0); PG8_MMA(1, 1, At, B1); PG8_BAR; PG8_SCHED;
            PG8_LDB(B0, 1, 0); PG8_LDB(B1, 1, 1); PG8_SCHED; PG8_LDA(At, 1, 0); PG8_STAGE(PG8_SA(0, 1), a2 + hstep, voffA);
            PG8_WAIT_V(8); PG8_WAIT_L(0); PG8_BAR; PG8_MMA(0, 0, At, B0); PG8_MMA(0, 1, At, B1); PG8_BAR; PG8_SCHED;
            PG8_LDA(At, 1, 1); PG8_STAGE(PG8_SB(1, 0), b3, voffB); PG8_STAGE(PG8_SB(1, 1), b3 + hstep, voffB); PG8_STAGE(PG8_SA(1, 0), a3, voffA);
            PG8_WAIT_V(8); PG8_WAIT_L(0); PG8_BAR; PG8_MMA(1, 0, At, B0); PG8_MMA(1, 1, At, B1); PG8_BAR; PG8_SCHED;
            } else {
            PG8_LDB(B0, 0, 0); PG8_SCHED; PG8_LDA(At, 0, 0); PG8_STAGE(PG8_SA(1, 1), a1 + hstep, voffA);
            PG8_WAIT_L(8); PG8_BAR; PG8_WAIT_L(0); PG8_MMA(0, 0, At, B0); PG8_BAR; PG8_SCHED;
            PG8_LDB(B1, 0, 1); PG8_STAGE(PG8_SB(0, 0), b2, voffB);
            PG8_BAR; PG8_WAIT_L(0); PG8_MMA(0, 1, At, B1); PG8_BAR;
            PG8_LDA(At, 0, 1); PG8_STAGE(PG8_SA(0, 0), a2, voffA);
            PG8_BAR; PG8_WAIT_L(0); PG8_MMA(1, 0, At, B0); PG8_BAR; PG8_SCHED;
            PG8_STAGE(PG8_SB(0, 1), b2 + hstep, voffB);
            PG8_WAIT_V(6); PG8_BAR; PG8_MMA(1, 1, At, B1); PG8_BAR;
            PG8_LDB(B0, 1, 0); PG8_SCHED; PG8_LDA(At, 1, 0); PG8_STAGE(PG8_SA(0, 1), a2 + hstep, voffA);
            PG8_WAIT_L(8); PG8_BAR; PG8_WAIT_L(0); PG8_MMA(0, 0, At, B0); PG8_BAR; PG8_SCHED;
            PG8_LDB(B1, 1, 1); PG8_STAGE(PG8_SB(1, 0), b3, voffB);
            PG8_BAR; PG8_WAIT_L(0); PG8_MMA(0, 1, At, B1); PG8_BAR;
            PG8_LDA(At, 1, 1); PG8_STAGE(PG8_SA(1, 0), a3, voffA);
            PG8_BAR; PG8_WAIT_L(0); PG8_MMA(1, 0, At, B0); PG8_BAR; PG8_SCHED;
            PG8_STAGE(PG8_SB(1, 1), b3 + hstep, voffB);
            PG8_WAIT_V(6); PG8_BAR; PG8_MMA(1, 1, At, B1); PG8_BAR;
            }
        }
        if constexpr (ALIGN_EPI) { if (wr == 0) PG8_BAR; }
        if constexpr (!Epi::AFTER_DRAIN) { E(acc, cur, wr, wc, fr, fq); S.done(cur); }
        if (!has_next) break;
#pragma unroll
        for (int a = 0; a < 2; ++a)
#pragma unroll
            for (int b = 0; b < 2; ++b)
#pragma unroll
                for (int m = 0; m < 4; ++m)
#pragma unroll
                    for (int n = 0; n < 2; ++n) acc[a][b][m][n] = (f32x4){0.f, 0.f, 0.f, 0.f};
        cur = nxt; cA = nA; cB = nB; ++ui;
        if constexpr (ALIGN_EPI) { if (wr == 1) PG8_BAR; }
    }
    PG8_WAIT_V(0);
    if constexpr (!ALIGN_EPI) { if (wr == 0) PG8_BAR; }
    PG8_BAR;
    if constexpr (Epi::AFTER_DRAIN) { E.fused(acc, cur, wr, wc, fr, fq, lds, wid, lane); S.done(cur); }
#undef PG8_SA
#undef PG8_SB
#undef PG8_STAGE
#undef PG8_LDA
#undef PG8_LDB
#undef PG8_MMA
#undef PG8_WAIT_V
#undef PG8_WAIT_L
#undef PG8_BAR
#undef PG8_SCHED
}
}

#ifndef MK_ONE_LAUNCH
#define MK_ONE_LAUNCH 1
#endif
constexpr int NWAVES = 8, NTHREADS = 512;
constexpr int DM = 1024, NB = 32, SEQ = 2048, DEPTH = 4, M_TOK = NB * SEQ;
constexpr int INC = 2304, FFH = 2816, NHEAD = 8;
constexpr int N_PHASES = 1 + 5 * DEPTH;
constexpr size_t MiB = 1u << 20;
constexpr size_t WS_WIN = 0;
constexpr size_t WS_WOUT = 18 * MiB;
constexpr size_t WS_WGU = 26 * MiB;
constexpr size_t WS_WDN = 70 * MiB;
constexpr size_t WS_WPW = 92 * MiB;
constexpr size_t WS_SS = 93 * MiB;
constexpr size_t WS_XB = 98 * MiB;
constexpr size_t WS_PROJ = 226 * MiB;
constexpr size_t WS_MIX = 514 * MiB;
constexpr size_t WS_HID = WS_PROJ;
constexpr size_t WS_END = 642 * MiB;
constexpr int LDS_BYTES = 147456;

#define LAS __attribute__((address_space(3)))
typedef unsigned short bf16;
typedef unsigned u32x4 __attribute__((ext_vector_type(4)));
typedef unsigned u32x2 __attribute__((ext_vector_type(2)));
typedef float f32x4 __attribute__((ext_vector_type(4)));
typedef float f32x16 __attribute__((ext_vector_type(16)));
typedef short bf16x8 __attribute__((ext_vector_type(8)));
typedef short s16x4 __attribute__((ext_vector_type(4)));

typedef float f32x2_t __attribute__((ext_vector_type(2))); typedef __bf16 bf16x2_t __attribute__((ext_vector_type(2)));
__device__ __forceinline__ unsigned pk2(float lo, float hi) { const f32x2_t v = {lo, hi}; const bf16x2_t b = __builtin_convertvector(v, bf16x2_t); return __builtin_bit_cast(unsigned, b); }
__device__ __forceinline__ float bflo(unsigned u) { return __builtin_bit_cast(float, u << 16); }
__device__ __forceinline__ float bfhi(unsigned u) { return __builtin_bit_cast(float, u & 0xffff0000u); }
__device__ __forceinline__ float wave_sum(float v) {
#pragma unroll
    for (int o = 1; o < 64; o <<= 1) v += __shfl_xor(v, o);
    return v;
}
__device__ __forceinline__ int tid_opaque() { int t = threadIdx.x; asm volatile("" : "+v"(t)); return t; }
__device__ __forceinline__ int crow(int r, int hi) { return (r & 3) + 8 * (r >> 2) + 4 * hi; }
__device__ __forceinline__ float sigmoidf_(float x) { return __builtin_amdgcn_rcpf(1.0f + __builtin_amdgcn_exp2f(-1.4426950408889634f * x)); }

constexpr int PT_OFF = 147200;
template <class T> __device__ __forceinline__ T* ldp(LAS unsigned char* lds, int k) {
    const unsigned long long v = ((const volatile LAS unsigned long long*)(lds + PT_OFF))[k];
    const unsigned lo = __builtin_amdgcn_readfirstlane((unsigned)v), hi = __builtin_amdgcn_readfirstlane((unsigned)(v >> 32));
    return (T*)(((unsigned long long)hi << 32) | lo);
}
#define PIN(k) ldp<const float>(lds, (k))
struct Args { const float* in[16]; float* out; unsigned char* ws; int ph_lo, ph_hi; };

typedef __attribute__((address_space(1))) unsigned gu32;
#define XB_TMO      128
#define XB_XCNT(j)  (256  + 64 * (j))
#define XB_XSUB(j)  (1280 + 64 * (j))
#define XB_XGEN(j)  (2304 + 64 * (j))
#define XB_TOP      3328
#define XB_TOPGEN   3392
#define XCD_BAR_WORDS 3456
#define XB_SPIN_CAP (1u << 18)

__device__ __forceinline__ unsigned xb_ld(unsigned* p)              { return __hip_atomic_load(p, __ATOMIC_RELAXED, __HIP_MEMORY_SCOPE_AGENT); }
__device__ __forceinline__ unsigned xb_add(unsigned* p, unsigned v) { return __hip_atomic_fetch_add(p, v, __ATOMIC_RELAXED, __HIP_MEMORY_SCOPE_AGENT); }
__device__ __forceinline__ unsigned xb_xcc_id() { return (unsigned)__builtin_amdgcn_s_getreg((3 << 11) | 20) & 0xFu; }
#define XB_SPIN(cond, bar) do { unsigned _sp = 0; while (cond) { __builtin_amdgcn_s_sleep(1); \
    if ((++_sp & 255u) == 0u) { if (xb_ld(&(bar)[XB_TMO])) break; if (_sp > XB_SPIN_CAP) { atomicAdd(&(bar)[XB_TMO], 1u); break; } } } } while (0)

struct XcdBarrier {
    unsigned* bar; unsigned x;
    volatile LAS unsigned* st;
};

__device__ __forceinline__ XcdBarrier xcd_barrier_post(unsigned* bar, volatile LAS unsigned* st) {
    XcdBarrier b; b.bar = bar; b.x = xb_xcc_id(); b.st = st;
    if (threadIdx.x == 0) (void)xb_add(&bar[XB_XCNT(b.x)], 1u);
    return b;
}
__device__ __forceinline__ void xcd_barrier_complete(unsigned* bar, unsigned x, unsigned& nloc, unsigned& nx) {
    const unsigned G = gridDim.x * gridDim.y * gridDim.z;
    unsigned sum, cnt, mine, sp = 0u;
    for (;;) {
        sum = 0u; cnt = 0u; mine = 0u;
#pragma unroll
        for (unsigned j = 0; j < 16; ++j) { const unsigned c = xb_ld(&bar[XB_XCNT(j)]); sum += c; cnt += (c > 0u) ? 1u : 0u; mine = (j == x) ? c : mine; }
        if (sum == G) break;
        __builtin_amdgcn_s_sleep(1);
        if ((++sp & 255u) == 0u) { if (xb_ld(&bar[XB_TMO])) break; if (sp > XB_SPIN_CAP) { atomicAdd(&bar[XB_TMO], 1u); break; } }
    }
    nloc = mine > 0u ? mine : 1u; nx = cnt > 0u ? cnt : 1u;
}

__device__ __forceinline__ void xcd_barrier(const XcdBarrier& b) {
    asm volatile("s_waitcnt vmcnt(0)" ::: "memory");
    __syncthreads();
    if (threadIdx.x == 0) {
        unsigned* bar = b.bar;
        __builtin_amdgcn_s_waitcnt(0);
        unsigned nloc = b.st[0], nx = b.st[1];
        if (nloc == 0u) { xcd_barrier_complete(bar, b.x, nloc, nx); b.st[0] = nloc; b.st[1] = nx; }
        const unsigned old = xb_add(&bar[XB_XSUB(b.x)], 1u);
        const unsigned gen = old / nloc;
        if (old + 1u == (gen + 1u) * nloc) {
            __builtin_amdgcn_fence(__ATOMIC_RELEASE, "agent");
            asm volatile("s_waitcnt vmcnt(0)" ::: "memory");
            const unsigned og = xb_add(&bar[XB_TOP], 1u);
            const unsigned tg = og / nx;
            if (og + 1u == (tg + 1u) * nx) xb_add(&bar[XB_TOPGEN], 1u);
            else XB_SPIN(xb_ld(&bar[XB_TOPGEN]) == tg, bar);
            __builtin_amdgcn_fence(__ATOMIC_ACQUIRE, "agent");
            xb_add(&bar[XB_XGEN(b.x)], 1u);
            asm volatile("s_waitcnt vmcnt(0)" ::: "memory");
        } else {
            XB_SPIN(xb_ld(&bar[XB_XGEN(b.x)]) == gen, bar);
            __builtin_amdgcn_fence(__ATOMIC_ACQUIRE, "agent");
            asm volatile("s_waitcnt vmcnt(0)" ::: "memory");
        }
    }
    __syncthreads();
}

constexpr size_t WS_BAR = 97 * MiB;
constexpr int BST_OFF = PT_OFF + 192;

__device__ __forceinline__ void tr64_fill(const float* W, int N, const float* s, int k0, int srcA, int srcB, LAS float* scr, int lane) {
    const int col4 = (lane & 15) * 4, src = col4 < 32 ? srcA + col4 : srcB + col4 - 32;
    f32x4 v[16];
#pragma unroll
    for (int i = 0; i < 16; ++i) v[i] = *(const f32x4*)(W + (size_t)(k0 + 4 * i + (lane >> 4)) * N + src);
#pragma unroll
    for (int i = 0; i < 16; ++i) { const int kk = 4 * i + (lane >> 4); const float sc = s ? s[k0 + kk] : 1.0f; LAS float* p = scr + kk * 65 + col4;
        p[0] = v[i][0] * sc; p[1] = v[i][1] * sc; p[2] = v[i][2] * sc; p[3] = v[i][3] * sc; }
}
__device__ __forceinline__ void tr64_flush(bf16* WT, int K, int k0, int dstA, int dstB, LAS float* scr, int lane) {
    asm volatile("s_waitcnt lgkmcnt(0)" ::: "memory");
    const int c = lane & 7;
#pragma unroll
    for (int j = 0; j < 8; ++j) { const int n = (lane >> 3) + 8 * j, row = n < 32 ? dstA + n : dstB + n - 32; const LAS float* p = scr + (8 * c) * 65 + n;
        u32x4 o; o.x = pk2(p[0 * 65], p[1 * 65]); o.y = pk2(p[2 * 65], p[3 * 65]); o.z = pk2(p[4 * 65], p[5 * 65]); o.w = pk2(p[6 * 65], p[7 * 65]);
        *(u32x4*)(WT + (size_t)row * K + k0 + 8 * c) = o; }
    asm volatile("s_waitcnt lgkmcnt(0)" ::: "memory");
}
__device__ __forceinline__ void pool_fill(const float* Win, const float* ng, const float* pw, const float* psc, int k0, int g, LAS float* scr, int lane) {
    float pc[64]; const float sc = psc[64 * g + lane];
#pragma unroll
    for (int i = 0; i < 64; ++i) pc[i] = pw[(size_t)(g * 64 + i) * 64 + lane] * sc;
    for (int kb = 0; kb < 64; kb += 4) {
        float wv[4];
#pragma unroll
        for (int q = 0; q < 4; ++q) wv[q] = Win[(size_t)(k0 + kb + q) * INC + 1536 + 64 * g + lane] * ng[k0 + kb + q];
#pragma unroll
        for (int q = 0; q < 4; ++q) { float acc = 0.f;
#pragma unroll
            for (int i = 0; i < 64; ++i) acc += __builtin_bit_cast(float, __builtin_amdgcn_readlane(__builtin_bit_cast(int, wv[q]), i)) * pc[i];
            scr[(kb + q) * 65 + lane] = acc; }
    }
}
__device__ __forceinline__ void p0_prologue(LAS unsigned char* lds, int G, int bid) {
    const int tid = tid_opaque(), lane = tid & 63, wave = __builtin_amdgcn_readfirstlane(tid >> 6);
    LAS float* scr = (LAS float*)(lds + wave * 16640);
    const int gw = bid * NWAVES + wave, NGW = G * NWAVES;
    unsigned char* ws = ldp<unsigned char>(lds, 17);
    constexpr int I_IN = 16 * 36, I_OUT = 16 * 16, I_GU = 16 * 88, I_DN = 44 * 16, I_PW = 4 * 4, I_L = I_IN + I_OUT + I_GU + I_DN + I_PW;
    for (int it = gw; it < DEPTH * I_L; it += NGW) {
        const int l = it / I_L; int r = it % I_L;
        if (r < I_IN) { const int kb = r / 36, nb = r % 36; const int nd = 64 * nb, pn = nd >> 8, bj = (nd >> 7) & 1, h2 = (nd >> 6) & 1;
            bf16* WT = (bf16*)(ws + WS_WIN) + (size_t)l * INC * DM;
            if (pn != 6) { const int sA = pn >= 7 ? 1792 + 256 * bj + 128 * (pn - 7) + 64 * h2 : 256 * pn + 128 * h2 + 32 * bj, sB = pn >= 7 ? sA + 32 : sA + 64;
                tr64_fill(PIN(2) + (size_t)l * DM * INC, INC, PIN(1) + l * DM, 64 * kb, sA, sB, scr, lane); tr64_flush(WT, DM, 64 * kb, nd, nd + 32, scr, lane); }
            else { const int g = nb - 24; pool_fill(PIN(2) + (size_t)l * DM * INC, PIN(1) + l * DM, PIN(5) + (size_t)l * 4 * 64 * 64, PIN(6) + l * 256, 64 * kb, g, scr, lane); tr64_flush(WT, DM, 64 * kb, 1536 + 32 * g, 1536 + 128 + 32 * g, scr, lane); }
            continue; }
        r -= I_IN;
        if (r < I_OUT) { const int kb = r / 16, nd = 64 * (r % 16); tr64_fill(PIN(12) + (size_t)l * DM * DM, DM, nullptr, 64 * kb, nd, nd + 32, scr, lane); tr64_flush((bf16*)(ws + WS_WOUT) + (size_t)l * DM * DM, DM, 64 * kb, nd, nd + 32, scr, lane); continue; }
        r -= I_OUT;
        if (r < I_GU) { const int kb = r / 88, nd = 64 * (r % 88); const int pn = nd >> 8, bj = (nd >> 7) & 1, q2 = (nd >> 6) & 1, src = bj * FFH + 128 * pn + 64 * q2;
            tr64_fill(PIN(14) + (size_t)l * DM * 2 * FFH, 2 * FFH, PIN(13) + l * DM, 64 * kb, src, src + 32, scr, lane); tr64_flush((bf16*)(ws + WS_WGU) + (size_t)l * 2 * FFH * DM, DM, 64 * kb, nd, nd + 32, scr, lane); continue; }
        r -= I_GU;
        if (r < I_DN) { const int kb = r / 16, nd = 64 * (r % 16); tr64_fill(PIN(15) + (size_t)l * FFH * DM, DM, nullptr, 64 * kb, nd, nd + 32, scr, lane); tr64_flush((bf16*)(ws + WS_WDN) + (size_t)l * DM * FFH, FFH, 64 * kb, nd, nd + 32, scr, lane); continue; }
        r -= I_DN;
        { const int kb = r / 4, nd = 64 * (r % 4); tr64_fill(PIN(11) + (size_t)l * 256 * 256, 256, nullptr, 64 * kb, nd, nd + 32, scr, lane); tr64_flush((bf16*)(ws + WS_WPW) + (size_t)l * 256 * 256, 256, 64 * kb, nd, nd + 32, scr, lane); }
    }
    const float* x = PIN(0); bf16* xb = (bf16*)(ws + WS_XB); float* ss = (float*)(ws + WS_SS);
    for (int m = 4 * gw; m < M_TOK; m += 4 * NGW) {
        f32x4 v[4][4]; float s[4];
#pragma unroll
        for (int q = 0; q < 4; ++q)
#pragma unroll
            for (int j = 0; j < 4; ++j) v[q][j] = ((const f32x4*)(x + (size_t)(m + q) * DM) + lane)[64 * j];
#pragma unroll
        for (int q = 0; q < 4; ++q) { s[q] = 0.f;
#pragma unroll
            for (int j = 0; j < 4; ++j) s[q] += (v[q][j][0] * v[q][j][0] + v[q][j][1] * v[q][j][1]) + (v[q][j][2] * v[q][j][2] + v[q][j][3] * v[q][j][3]); }
#pragma unroll
        for (int q = 0; q < 4; ++q) s[q] = wave_sum(s[q]);
#pragma unroll
        for (int q = 0; q < 4; ++q) {
            u32x2* o8 = (u32x2*)(xb + (size_t)(m + q) * DM) + lane;
#pragma unroll
            for (int j = 0; j < 4; ++j) { u32x2 w; w.x = pk2(v[q][j][0], v[q][j][1]); w.y = pk2(v[q][j][2], v[q][j][3]); o8[64 * j] = w; }
            if (lane < 16) ss[(size_t)(m + q) * 16 + lane] = lane == 0 ? s[q] : 0.f; }
    }
}

constexpr int AT_K0 = 0, AT_V0 = 8192, AT_BUF = 16384, AT_FLAGS = 32768;
__device__ __forceinline__ f32x16 at_qk(const LAS unsigned char* kb, const bf16x8 (&qr)[4]) {
    f32x16 s = {};
#pragma unroll
    for (int d0 = 0; d0 < 4; ++d0) { const bf16x8 kf = *(const LAS bf16x8*)(kb + d0 * 2048); s = __builtin_amdgcn_mfma_f32_32x32x16_bf16(kf, qr[d0], s, 0, 0, 0); }
    return s;
}
__device__ __forceinline__ void at_sb(const f32x16& s, bool diag, int r32, int hi, float& carry, u32x4& pa0, u32x4& pa1) {
    float E[16], uu[16], wv[16];
#pragma unroll
    for (int r = 0; r < 16; ++r) { E[r] = __builtin_amdgcn_exp2f(s[r]); uu[r] = 1.0f + E[r]; }
    if (diag) {
#pragma unroll
        for (int r = 0; r < 16; ++r) { const bool valid = crow(r, hi) < r32; uu[r] = valid ? uu[r] : 1.0f; E[r] = valid ? E[r] : 0.0f; }
    }
    float g[4], og[4];
#pragma unroll
    for (int bq = 0; bq < 4; ++bq)
        g[bq] = __builtin_amdgcn_rcpf(((uu[4 * bq + 3] * uu[4 * bq + 2]) * uu[4 * bq + 1]) * uu[4 * bq + 0]);
#pragma unroll
    for (int bq = 0; bq < 4; ++bq) {
        const unsigned own = __builtin_bit_cast(unsigned, g[bq]);
        const auto sw = __builtin_amdgcn_permlane32_swap(own, own, false, false);
        og[bq] = __builtin_bit_cast(float, hi ? sw[0] : sw[1]);
    }
    float pre = carry;
#pragma unroll
    for (int bq = 3; bq >= 0; --bq) {
        const float mine = hi ? pre : pre * og[bq];
        const float i0 = g[bq] * mine, i1 = i0 * uu[4 * bq + 0], i2 = i1 * uu[4 * bq + 1], i3 = i2 * uu[4 * bq + 2];
        wv[4 * bq + 0] = E[4 * bq + 0] * i0; wv[4 * bq + 1] = E[4 * bq + 1] * i1; wv[4 * bq + 2] = E[4 * bq + 2] * i2; wv[4 * bq + 3] = E[4 * bq + 3] * i3;
        pre *= g[bq] * og[bq];
    }
    carry = pre;
    pa0.x = pk2(wv[0], wv[1]); pa0.y = pk2(wv[2], wv[3]); pa0.z = pk2(wv[4], wv[5]); pa0.w = pk2(wv[6], wv[7]);
    pa1.x = pk2(wv[8], wv[9]); pa1.y = pk2(wv[10], wv[11]); pa1.z = pk2(wv[12], wv[13]); pa1.w = pk2(wv[14], wv[15]);
}
__device__ __forceinline__ void at_pv(const LAS unsigned char* vbase, int p, const u32x4& pa0, const u32x4& pa1, f32x16& o0, f32x16& o1) {
#pragma unroll
    for (int sq = 0; sq < 2; ++sq) {
        const bf16x8 pa = __builtin_bit_cast(bf16x8, sq ? pa1 : pa0); const int ks = 2 * p + sq;
#pragma unroll
        for (int d0 = 0; d0 < 2; ++d0) {
            const s16x4 lo = __builtin_bit_cast(s16x4, __builtin_amdgcn_ds_read_tr16_b64_v4i16((LAS s16x4*)(vbase + d0 * 4096 + ks * 1024)));
            const s16x4 hh = __builtin_bit_cast(s16x4, __builtin_amdgcn_ds_read_tr16_b64_v4i16((LAS s16x4*)(vbase + d0 * 4096 + ks * 1024 + 512)));
            const bf16x8 vf = (bf16x8){lo[0], lo[1], lo[2], lo[3], hh[0], hh[1], hh[2], hh[3]};
            if (d0 == 0) o0 = __builtin_amdgcn_mfma_f32_32x32x16_bf16(pa, vf, o0, 0, 0, 0); else o1 = __builtin_amdgcn_mfma_f32_32x32x16_bf16(pa, vf, o1, 0, 0, 0);
        }
    }
}
__device__ __forceinline__ void attn_phase(LAS unsigned char* lds, const bf16* proj, bf16* mix, int G, int bid) {
    const int tid = tid_opaque(), lane = tid & 63, r32 = lane & 31, hi = lane >> 5, wid = __builtin_amdgcn_readfirstlane(tid >> 6);
    bf16x8 qn[4]; u32x4 kn = {}, vn = {};
    if (bid < NB * NHEAD * 8) { const int bh = bid & 255, qb = 7 - (bid >> 8), b = bh >> 3, h = bh & 7; const size_t rowbase = (size_t)b * SEQ; const int nt = 4 * qb + 4;
#pragma unroll
        for (int d0 = 0; d0 < 4; ++d0) qn[d0] = *(const bf16x8*)(proj + (rowbase + qb * 256 + wid * 32 + r32) * INC + h * 64 + d0 * 16 + hi * 8);
        kn = *(const u32x4*)(proj + rowbase * INC + 512 + h * 64 + (size_t)lane * INC + wid * 8 + (size_t)(nt - 1) * 64 * INC);
        vn = *(const u32x4*)(proj + rowbase * INC + 1024 + h * 64 + (size_t)(16 * (wid & 3) + (lane >> 2)) * INC + (wid >> 2) * 32 + (lane & 3) * 8 + (size_t)(nt - 1) * 64 * INC); }
    for (int u = bid; u < NB * NHEAD * 8; u += G) {
        const int bh = u & 255, qb = 7 - (u >> 8), b = bh >> 3, h = bh & 7;
        const size_t rowbase = (size_t)b * SEQ; const int q0 = qb * 256, Q0 = q0 + wid * 32;
        const bf16* Kp = proj + rowbase * INC + 512 + h * 64 + (size_t)lane * INC + wid * 8;
        const bf16* Vp = proj + rowbase * INC + 1024 + h * 64 + (size_t)(16 * (wid & 3) + (lane >> 2)) * INC + (wid >> 2) * 32 + (lane & 3) * 8;
        bf16x8 qr[4];
#pragma unroll
        for (int d0 = 0; d0 < 4; ++d0) qr[d0] = qn[d0];
        const int nt = 4 * qb + 4;
        u32x4 kreg = kn, vreg = vn;
        if (u + G < NB * NHEAD * 8) { const int u2 = u + G, bh2 = u2 & 255, qb2 = 7 - (u2 >> 8), b2 = bh2 >> 3, h2 = bh2 & 7; const size_t rb2 = (size_t)b2 * SEQ; const int nt2 = 4 * qb2 + 4;
#pragma unroll
            for (int d0 = 0; d0 < 4; ++d0) qn[d0] = *(const bf16x8*)(proj + (rb2 + qb2 * 256 + wid * 32 + r32) * INC + h2 * 64 + d0 * 16 + hi * 8);
            kn = *(const u32x4*)(proj + rb2 * INC + 512 + h2 * 64 + (size_t)lane * INC + wid * 8 + (size_t)(nt2 - 1) * 64 * INC);
            vn = *(const u32x4*)(proj + rb2 * INC + 1024 + h2 * 64 + (size_t)(16 * (wid & 3) + (lane >> 2)) * INC + (wid >> 2) * 32 + (lane & 3) * 8 + (size_t)(nt2 - 1) * 64 * INC); }
        __syncthreads();
        *(LAS u32x4*)(lds + AT_K0 + wid * 1024 + lane * 16) = kreg; *(LAS u32x4*)(lds + AT_V0 + wid * 1024 + lane * 16) = vreg;
        kreg = *(const u32x4*)(Kp + (size_t)(nt - 2) * 64 * INC); vreg = *(const u32x4*)(Vp + (size_t)(nt - 2) * 64 * INC);
        float carry = 1.0f; f32x16 o0 = {}, o1 = {};
        int cur = 0;
        for (int j = nt - 1; j >= 0; --j) {
            __syncthreads();
            if (j < nt - 1) {
                const LAS unsigned* fl = (const LAS unsigned*)(lds + AT_FLAGS) + ((j + 1) & 1) * 8;
                const u32x4 f0 = *(const LAS u32x4*)fl, f1 = *(const LAS u32x4*)(fl + 4);
                const unsigned alld = (f0[0] & f0[1] & f0[2] & f0[3]) & (f1[0] & f1[1] & f1[2] & f1[3]);
                if (__builtin_amdgcn_readfirstlane(alld) != 0u) break;
            }
            if (j > 0) { *(LAS u32x4*)(lds + (cur ^ 1) * AT_BUF + AT_K0 + wid * 1024 + lane * 16) = kreg; *(LAS u32x4*)(lds + (cur ^ 1) * AT_BUF + AT_V0 + wid * 1024 + lane * 16) = vreg; }
            if (j > 1) { kreg = *(const u32x4*)(Kp + (size_t)(j - 2) * 64 * INC); vreg = *(const u32x4*)(Vp + (size_t)(j - 2) * 64 * INC); }
            const LAS unsigned char* kbase = lds + cur * AT_BUF + AT_K0 + hi * 1024 + r32 * 16;
            const LAS unsigned char* vbase = lds + cur * AT_BUF + AT_V0 + ((lane >> 4) & 1) * 32 + (lane & 3) * 8 + (4 * hi + ((lane & 15) >> 2)) * 64;
            u32x4 pa0, pa1;
            if (__all(carry == 0.0f)) {   }
            else if (64 * j + 32 < Q0) {
                const f32x16 s1 = at_qk(kbase + 512, qr), s0 = at_qk(kbase, qr);
                at_sb(s1, false, r32, hi, carry, pa0, pa1); at_pv(vbase, 1, pa0, pa1, o0, o1);
                at_sb(s0, false, r32, hi, carry, pa0, pa1); at_pv(vbase, 0, pa0, pa1, o0, o1);
            } else {
#pragma unroll
                for (int pp = 0; pp < 2; ++pp) {
                    const int p = 1 - pp, s0i = 64 * j + 32 * p;
                    if (s0i > Q0) continue;
                    const f32x16 s = at_qk(kbase + p * 512, qr);
                    at_sb(s, s0i == Q0, r32, hi, carry, pa0, pa1); at_pv(vbase, p, pa0, pa1, o0, o1);
                }
            }
            { const unsigned dn = __all(carry == 0.0f) ? 1u : 0u;
              if (lane == 0) ((LAS unsigned*)(lds + AT_FLAGS))[(j & 1) * 8 + wid] = dn; }
            cur ^= 1;
        }
        bf16* Op = mix + (rowbase + Q0) * DM + h * 64 + r32;
#pragma unroll
        for (int r = 0; r < 16; ++r) { bf16* p = Op + (size_t)crow(r, hi) * DM; p[0] = (bf16)(pk2(o0[r], 0.f) & 0xffffu); p[32] = (bf16)(pk2(o1[r], 0.f) & 0xffffu); }
    }
}

__device__ __forceinline__ void unpk8(const u32x4 v, float (&f)[8]) { f[0] = bflo(v.x); f[1] = bfhi(v.x); f[2] = bflo(v.y); f[3] = bfhi(v.y); f[4] = bflo(v.z); f[5] = bfhi(v.z); f[6] = bflo(v.w); f[7] = bfhi(v.w); }
template <int W> __device__ __forceinline__ void pool_item(const bf16* proj, bf16* mix, int tok0, int c) {
    const int t0 = tok0 & (SEQ - 1);
    u32x4 raw[W + 3];
#pragma unroll
    for (int r = 0; r < W + 3; ++r) { const int dt = r - (W - 1); raw[r] = (u32x4){0u, 0u, 0u, 0u}; if (t0 + dt >= 0) raw[r] = *(const u32x4*)(proj + (size_t)(tok0 + dt) * INC + 1536 + c); }
    float s[8], f[8];
#pragma unroll
    for (int k = 0; k < 8; ++k) s[k] = 0.f;
#pragma unroll
    for (int r = 0; r < W; ++r) { unpk8(raw[r], f);
#pragma unroll
        for (int k = 0; k < 8; ++k) s[k] += f[k]; }
#pragma unroll
    for (int i = 0; i < 4; ++i) {
        float m0[8]; unpk8(raw[W - 1 + i], m0);
        if (i > 0) { unpk8(raw[i - 1], f);
#pragma unroll
            for (int k = 0; k < 8; ++k) s[k] += m0[k] - f[k]; }
        const int cnt = (t0 + i + 1) < W ? (t0 + i + 1) : W; const float inv = 1.0f / (float)cnt;
        u32x4 o; o.x = pk2(s[0] * inv - m0[0], s[1] * inv - m0[1]); o.y = pk2(s[2] * inv - m0[2], s[3] * inv - m0[3]); o.z = pk2(s[4] * inv - m0[4], s[5] * inv - m0[5]); o.w = pk2(s[6] * inv - m0[6], s[7] * inv - m0[7]);
        *(u32x4*)(mix + (size_t)(tok0 + i) * DM + 512 + c) = o;
    }
}
__device__ __forceinline__ void pool_phase(const bf16* proj, bf16* mix, int G, int bid) {
    const int tid = tid_opaque(), lane = tid & 63, wave = tid >> 6;
    for (int wi = bid * NWAVES + wave; wi < 4 * (M_TOK / 32); wi += G * NWAVES) {
        const int g = wi & 3, tok0 = ((wi >> 2) * 8 + (lane >> 3)) * 4, c = 64 * g + 8 * (lane & 7);
        if (g == 0) pool_item<2>(proj, mix, tok0, c); else if (g == 1) pool_item<4>(proj, mix, tok0, c); else if (g == 2) pool_item<8>(proj, mix, tok0, c); else pool_item<16>(proj, mix, tok0, c);
    }
}

constexpr int CV_ROWS = 94, CV_AB = CV_ROWS * 256 * 4  , CV_APITCH = 528;
__device__ __forceinline__ void conv_phase(LAS unsigned char* lds, const bf16* proj, bf16* mix, const float* cw, const float* cb, const float* lng, const float* lnb, const bf16* pwT, int G, int bid) {
    LAS float* hb = (LAS float*)lds; LAS unsigned char* ab = lds + CV_AB;
    const int tid = tid_opaque(), lane = tid & 63, r32 = lane & 31, hi = lane >> 5, wid = __builtin_amdgcn_readfirstlane(tid >> 6);
    const int c = tid & 255, half = tid >> 8;
    if (bid >= M_TOK / 64) return;
    bf16x8 pwf[16];
#pragma unroll
    for (int kk = 0; kk < 16; ++kk) pwf[kk] = *(const bf16x8*)(pwT + (size_t)(32 * wid + r32) * 256 + 16 * kk + 8 * hi);
    float w[31];
#pragma unroll
    for (int j = 0; j < 31; ++j) w[j] = cw[j * 256 + c];
    const float bias = cb[c];
    const f32x4 gg = *(const f32x4*)(lng + 4 * lane), bb = *(const f32x4*)(lnb + 4 * lane);
    for (int tile = bid; tile < M_TOK / 64; tile += G) {
        const int tok0 = tile * 64, t0 = tok0 & (SEQ - 1);
        u32x4 av[6];
#pragma unroll
        for (int k = 0; k < 6; ++k) { const int it = tid + NTHREADS * k, i = it >> 5, c8 = (it & 31) * 8; av[k] = (u32x4){0u, 0u, 0u, 0u};
            if (it < CV_ROWS * 32 && t0 - 30 + i >= 0) av[k] = *(const u32x4*)(proj + (size_t)(tok0 - 30 + i) * INC + 1792 + c8); }
        __syncthreads();
#pragma unroll
        for (int k = 0; k < 6; ++k) { const int it = tid + NTHREADS * k, i = it >> 5, c8 = (it & 31) * 8;
            if (it < CV_ROWS * 32) { float a8[8]; unpk8(av[k], a8);
                *(LAS f32x4*)(hb + i * 256 + c8) = (f32x4){a8[0], a8[1], a8[2], a8[3]}; *(LAS f32x4*)(hb + i * 256 + c8 + 4) = (f32x4){a8[4], a8[5], a8[6], a8[7]}; } }
        __syncthreads();
        float in[62];
#pragma unroll
        for (int i = 0; i < 62; ++i) in[i] = hb[(32 * half + i) * 256 + c];
        __syncthreads();
#pragma unroll
        for (int t = 0; t < 32; ++t) { float acc = bias;
#pragma unroll
            for (int j = 0; j < 31; ++j) acc += w[j] * in[t + j];
            hb[(32 * half + t) * 256 + c] = acc; }
        __syncthreads();
#pragma unroll
        for (int tt = 0; tt < 8; ++tt) { const int tk = 8 * wid + tt; const f32x4 v = *(const LAS f32x4*)(hb + tk * 256 + 4 * lane);
            const float mean = wave_sum((v[0] + v[1]) + (v[2] + v[3])) * (1.0f / 256.0f); const f32x4 d = v - mean;
            const float var = wave_sum((d[0] * d[0] + d[1] * d[1]) + (d[2] * d[2] + d[3] * d[3])) * (1.0f / 256.0f); const float rstd = __builtin_amdgcn_rsqf(var + 1e-5f);
            f32x4 y = d * rstd * gg + bb;
#pragma unroll
            for (int i = 0; i < 4; ++i) y[i] = y[i] * sigmoidf_(y[i]);
            u32x2 o; o.x = pk2(y[0], y[1]); o.y = pk2(y[2], y[3]); *(LAS u32x2*)(ab + tk * CV_APITCH + lane * 8) = o; }
        __syncthreads();
        f32x16 a0 = {}, a1 = {};
#pragma unroll
        for (int kk = 0; kk < 16; ++kk) {
            const bf16x8 f0 = *(const LAS bf16x8*)(ab + r32 * CV_APITCH + (16 * kk + 8 * hi) * 2), f1 = *(const LAS bf16x8*)(ab + (r32 + 32) * CV_APITCH + (16 * kk + 8 * hi) * 2);
            a0 = __builtin_amdgcn_mfma_f32_32x32x16_bf16(f0, pwf[kk], a0, 0, 0, 0); a1 = __builtin_amdgcn_mfma_f32_32x32x16_bf16(f1, pwf[kk], a1, 0, 0, 0);
        }
        bf16* Op = mix + (size_t)tok0 * DM + 768 + 32 * wid + r32;
#pragma unroll
        for (int r = 0; r < 16; ++r) { Op[(size_t)crow(r, hi) * DM] = (bf16)(pk2(a0[r], 0.f) & 0xffffu); Op[(size_t)(crow(r, hi) + 32) * DM] = (bf16)(pk2(a1[r], 0.f) & 0xffffu); }
    }
}

__global__ void __launch_bounds__(NTHREADS, 2) mk_fwd(Args a) {
    extern __shared__ __attribute__((aligned(16))) unsigned char lds_raw[];
    LAS unsigned char* lds = (LAS unsigned char*)lds_raw;
    const int G = gridDim.x, bid = blockIdx.x;
    if (threadIdx.x == 0) { LAS unsigned long long* PT = (LAS unsigned long long*)(lds + PT_OFF);
        PT[0] = (unsigned long long)a.in[0]; PT[1] = (unsigned long long)a.in[1]; PT[2] = (unsigned long long)a.in[2]; PT[3] = (unsigned long long)a.in[3];
        PT[4] = (unsigned long long)a.in[4]; PT[5] = (unsigned long long)a.in[5]; PT[6] = (unsigned long long)a.in[6]; PT[7] = (unsigned long long)a.in[7];
        PT[8] = (unsigned long long)a.in[8]; PT[9] = (unsigned long long)a.in[9]; PT[10] = (unsigned long long)a.in[10]; PT[11] = (unsigned long long)a.in[11];
        PT[12] = (unsigned long long)a.in[12]; PT[13] = (unsigned long long)a.in[13]; PT[14] = (unsigned long long)a.in[14]; PT[15] = (unsigned long long)a.in[15];
        PT[16] = (unsigned long long)a.out; PT[17] = (unsigned long long)a.ws; }
    if (threadIdx.x == 0) { ((volatile LAS unsigned*)(lds + BST_OFF))[0] = 0u; ((volatile LAS unsigned*)(lds + BST_OFF))[1] = 0u; }
    const int ph_hi = a.ph_hi;
    __syncthreads();
    if (MK_ONE_LAUNCH) (void)xcd_barrier_post((unsigned*)(a.ws + WS_BAR), (volatile LAS unsigned*)(lds + BST_OFF));
    for (int ph = a.ph_lo; ph < ph_hi; ++ph) {
        if (ph == 0) {
            p0_prologue(lds, G, bid);
        }
        else {
            const int l = (ph - 1) / 5, sp = (ph - 1) % 5;
            unsigned char* ws = ldp<unsigned char>(lds, 17);
            bf16* xb = (bf16*)(ws + WS_XB); float* ss = (float*)(ws + WS_SS); bf16* proj = (bf16*)(ws + WS_PROJ); bf16* mix = (bf16*)(ws + WS_MIX); bf16* hid = (bf16*)(ws + WS_HID);
            if (sp == 1) {
                attn_phase(lds, proj, mix, G, bid);
                asm volatile("" ::: "memory");
                pool_phase(proj, mix, G, bid);
                asm volatile("" ::: "memory");
                conv_phase(lds, proj, mix, PIN(7) + l * 31 * 256, PIN(8) + l * 256, PIN(9) + l * 256, PIN(10) + l * 256, (const bf16*)(ws + WS_WPW) + (size_t)l * 256 * 256, G, bid);
            } else {
                pg8::Gemm g; pg8::EpiAny E; float* outp = ldp<float>(lds, 16);
                E.ss_in = ss; E.ss_out = ss; E.out = outp; E.qg = PIN(3) + l * 64; E.kg = PIN(4) + l * 64;
                if (sp == 0)      { g = pg8::Gemm{xb, (const bf16*)(ws + WS_WIN) + (size_t)l * INC * DM, M_TOK, INC, DM}; E.kind = 0; E.ob = proj; }
                else if (sp == 2) { g = pg8::Gemm{mix, (const bf16*)(ws + WS_WOUT) + (size_t)l * DM * DM, M_TOK, DM, DM}; E.kind = 1; E.ob = xb; }
                else if (sp == 3) { g = pg8::Gemm{xb, (const bf16*)(ws + WS_WGU) + (size_t)l * 2 * FFH * DM, M_TOK, 2 * FFH, DM}; E.kind = 2; E.ob = hid; }
                else              { g = pg8::Gemm{hid, (const bf16*)(ws + WS_WDN) + (size_t)l * DM * FFH, M_TOK, DM, FFH}; E.kind = (l == DEPTH - 1) ? 6 : 1; E.ob = xb; }
                pg8::StaticOrder S; S.init(g.M, g.N, G, bid);
                asm volatile("" ::: "memory");
                pg8::gemm_phase<pg8::EpiAny, pg8::StaticOrder, true, true>(lds, g, S, E);
            }
        }
        if (ph + 1 < ph_hi) { {
            if (ph == 0) cg::this_grid().sync();
            else { XcdBarrier xb; xb.bar = (unsigned*)(ldp<unsigned char>(lds, 17) + WS_BAR); xb.x = xb_xcc_id(); xb.st = (volatile LAS unsigned*)(lds + BST_OFF); xcd_barrier(xb); } } }
    }
}

extern "C" void kernel_launch(void* const* d_in, const int* in_sizes, int n_in, void* d_out, int out_size, void* d_ws, size_t ws_size, hipStream_t stream) {
    static int grid = 0;
    if (grid == 0) {
        if (n_in != 16 || in_sizes[0] != M_TOK * DM || out_size != M_TOK * DM || ws_size < WS_END) { fprintf(stderr, "kernel_launch: unexpected shapes (n_in %d, in0 %d, out %d, ws %zu)\n", n_in, n_in > 0 ? in_sizes[0] : -1, out_size, ws_size); grid = -1; return; }
        int dev = 0, cus = 0, per_cu = 0;
        if (hipGetDevice(&dev) != hipSuccess || hipDeviceGetAttribute(&cus, hipDeviceAttributeMultiprocessorCount, dev) != hipSuccess) { grid = -1; return; }
        if (hipFuncSetAttribute((const void*)mk_fwd, hipFuncAttributeMaxDynamicSharedMemorySize, LDS_BYTES) != hipSuccess) { fprintf(stderr, "kernel_launch: hipFuncSetAttribute failed\n"); grid = -1; return; }
        if (hipOccupancyMaxActiveBlocksPerMultiprocessor(&per_cu, (const void*)mk_fwd, NTHREADS, LDS_BYTES) != hipSuccess || per_cu < 1) { fprintf(stderr, "kernel_launch: occupancy query says %d\n", per_cu); per_cu = 1; }
        (void)hipGetLastError();
        grid = cus * per_cu;
    }
    if (grid < 0) return;
    if (MK_ONE_LAUNCH) { if (hipMemsetAsync((char*)d_ws + WS_BAR, 0, 16384, stream) != hipSuccess) { fprintf(stderr, "kernel_launch: memset failed\n"); return; } }
    Args a{};
    for (int i = 0; i < 16; ++i) a.in[i] = (const float*)d_in[i];
    a.out = (float*)d_out; a.ws = (unsigned char*)d_ws;
#if MK_ONE_LAUNCH
    a.ph_lo = 0; a.ph_hi = N_PHASES;
    void* args[] = {&a};
    hipError_t e = hipLaunchCooperativeKernel((const void*)mk_fwd, dim3(grid), dim3(NTHREADS), args, LDS_BYTES, stream);
    if (e != hipSuccess) fprintf(stderr, "kernel_launch: cooperative launch failed: %s (grid %d)\n", hipGetErrorString(e), grid);
#else
    for (int ph = 0; ph < N_PHASES; ++ph) { a.ph_lo = ph; a.ph_hi = ph + 1; hipLaunchKernelGGL(mk_fwd, dim3(grid), dim3(NTHREADS), LDS_BYTES, stream, a); }
#endif
}
```

```cpp
#define MK_ONE_LAUNCH 1
#include <hip/hip_runtime.h>
#include <hip/hip_cooperative_groups.h>
#include <cstdio>
#include <cstdint>
namespace cg = cooperative_groups;
namespace pg8 {
#define PG8_LAS __attribute__((address_space(3)))
typedef unsigned short bf16_t;
typedef short bf16x8 __attribute__((ext_vector_type(8)));
typedef float f32x4 __attribute__((ext_vector_type(4)));
typedef unsigned u32x4 __attribute__((ext_vector_type(4)));
constexpr int BM = 256, BK = 64, HALF = 128, HTB = HALF * BK * 2  , STAGE_BYTES = 8 * HTB, NXCD = 8, WGM = 8;

__host__ __device__ __forceinline__ int lds_byte(int r, int c) { const int st = (r >> 4) * 2 + (c >> 5), rr = r & 15, cc = c & 31, ob = rr * 64 + cc * 2; return st * 1024 + (ob ^ (((ob >> 9) & 1) << 5)); }
__host__ __device__ __forceinline__ void stage_rc(int b, int& R, int& C) { const int st = b / 1024, sb = b % 1024, swz = sb ^ (((sb >> 9) & 1) << 5); R = (st >> 1) * 16 + swz / 64; C = (st & 1) * 32 + (swz % 64) / 2; }
__host__ __device__ __forceinline__ int perm32(int rho) { const int n = rho >> 4, i = rho & 15; return 8 * (i >> 2) + 4 * n + (i & 3); }

struct Unit { int pm, pn; };
struct Gemm { const bf16_t* A; const bf16_t* Bt; int M, N, K; };

struct StaticOrder {
    int nM, nN, nwg, G, c;
    __host__ __device__ void init(int M, int N, int G_, int c_) { nM = M / BM; nN = N / BM; nwg = nM * nN; G = G_; c = c_; }
    __host__ __device__ bool next(int i, Unit& u) const {
        const long L = (long)i * G + c; if (L >= nwg) return false;
        int wgid = (int)L; { const int q = nwg / NXCD, r = nwg % NXCD, xcd = wgid % NXCD, off = wgid / NXCD; wgid = (xcd < r ? xcd * (q + 1) : r * (q + 1) + (xcd - r) * q) + off; }
        const int nig = WGM * nN, gid = wgid / nig, fm = gid * WGM, gsz = (nM - fm) < WGM ? (nM - fm) : WGM;
        u.pm = fm + ((wgid % nig) % gsz); u.pn = (wgid % nig) / gsz; return true;
    }
    __device__ __forceinline__ void a_ready(const Unit&) const {}
    __device__ __forceinline__ void done(const Unit&) const {}
};
typedef float f32x2 __attribute__((ext_vector_type(2))); typedef __bf16 pg8_bf16x2 __attribute__((ext_vector_type(2)));
__device__ __forceinline__ unsigned cvt_pk_bf16(float lo, float hi) { const f32x2 v = {lo, hi}; const pg8_bf16x2 b = __builtin_convertvector(v, pg8_bf16x2); return __builtin_bit_cast(unsigned, b); }
typedef unsigned u32x4 __attribute__((ext_vector_type(4)));
__device__ __forceinline__ float xor32_add(float v, int fq) { const unsigned b = __builtin_bit_cast(unsigned, v); const auto sw = __builtin_amdgcn_permlane32_swap(b, b, false, false); return v + __builtin_bit_cast(float, (fq >> 1) ? sw[0] : sw[1]); }
__device__ __forceinline__ void row_rstd(const float* ss, int row0, int fq, float (&rs)[2][4]) {
#pragma unroll
    for (int ai = 0; ai < 2; ++ai)
#pragma unroll
        for (int m = 0; m < 4; ++m) {
            const f32x4 v = *(const f32x4*)(ss + (size_t)(row0 + ai * HALF + m * 16) * 16 + 4 * fq);
            float s = (v[0] + v[1]) + (v[2] + v[3]);
            s += __shfl_xor(s, 16); s = xor32_add(s, fq);
            rs[ai][m] = __builtin_amdgcn_rsqf(s * (1.0f / 1024.0f) + 1e-6f)    ;
        }
}
struct EpiInProj {
    static constexpr bool PERM = true, AFTER_DRAIN = false;
    bf16_t* P; const float* ss; const float* qg; const float* kg;
    __device__ __forceinline__ void operator()(const f32x4 (&acc)[2][2][4][2], const Unit& u, int wr, int wc, int fr, int fq) const {
        const int row0 = u.pm * BM + wr * 64 + fr;
        float rs[2][4]; row_rstd(ss, row0, fq, rs);
        if (u.pn >= 7) {
#pragma unroll
            for (int ai = 0; ai < 2; ++ai)
#pragma unroll
                for (int m = 0; m < 4; ++m) { const float r = rs[ai][m]; f32x4 h[2];
#pragma unroll
                    for (int n = 0; n < 2; ++n) { const f32x4 a = acc[ai][0][m][n] * r, gt = acc[ai][1][m][n] * r;
#pragma unroll
                        for (int i = 0; i < 4; ++i) h[n][i] = a[i] * __builtin_amdgcn_rcpf(1.0f + __builtin_amdgcn_exp2f(-1.4426950408889634f * gt[i])); }
                    u32x4 w; w.x = cvt_pk_bf16(h[0][0], h[0][1]); w.y = cvt_pk_bf16(h[0][2], h[0][3]); w.z = cvt_pk_bf16(h[1][0], h[1][1]); w.w = cvt_pk_bf16(h[1][2], h[1][3]);
                    *(u32x4*)(P + (size_t)(row0 + ai * HALF + m * 16) * 2304 + 1792 + 128 * (u.pn - 7) + 32 * wc + 8 * fq) = w; }
            return;
        }
        const bool isq = u.pn < 2, isk = (u.pn >= 2 && u.pn < 4), hn = isq || isk;
        f32x4 gv[2][2];
#pragma unroll
        for (int bj = 0; bj < 2; ++bj)
#pragma unroll
            for (int n = 0; n < 2; ++n) gv[bj][n] = (f32x4){1.f, 1.f, 1.f, 1.f};
        if (hn) { const float* g = isq ? qg : kg; const float sc = isq ? 0.125f * 1.4426950408889634f : 1.0f;
#pragma unroll
            for (int bj = 0; bj < 2; ++bj)
#pragma unroll
                for (int n = 0; n < 2; ++n) gv[bj][n] = *(const f32x4*)(g + 32 * bj + 8 * fq + 4 * n) * sc; }
#pragma unroll
        for (int ai = 0; ai < 2; ++ai)
#pragma unroll
            for (int m = 0; m < 4; ++m) {
                const float r = rs[ai][m];
                f32x4 v[2][2];
#pragma unroll
                for (int bj = 0; bj < 2; ++bj)
#pragma unroll
                    for (int n = 0; n < 2; ++n) v[bj][n] = acc[ai][bj][m][n] * r;
                if (hn) {
                    float q = 0.f;
#pragma unroll
                    for (int bj = 0; bj < 2; ++bj)
#pragma unroll
                        for (int n = 0; n < 2; ++n) { const f32x4 x = v[bj][n]; q += (x[0] * x[0] + x[1] * x[1]) + (x[2] * x[2] + x[3] * x[3]); }
                    q += __shfl_xor(q, 16); q = xor32_add(q, fq);
                    const float hr = __builtin_amdgcn_rsqf(q * (1.0f / 64.0f) + 1e-6f);
#pragma unroll
                    for (int bj = 0; bj < 2; ++bj)
#pragma unroll
                        for (int n = 0; n < 2; ++n) v[bj][n] = v[bj][n] * hr * gv[bj][n];
                }
                bf16_t* rowp = P + (size_t)(row0 + ai * HALF + m * 16) * 2304 + u.pn * BM + 64 * wc + 8 * fq;
#pragma unroll
                for (int bj = 0; bj < 2; ++bj) { u32x4 w; w.x = cvt_pk_bf16(v[bj][0][0], v[bj][0][1]); w.y = cvt_pk_bf16(v[bj][0][2], v[bj][0][3]); w.z = cvt_pk_bf16(v[bj][1][0], v[bj][1][1]); w.w = cvt_pk_bf16(v[bj][1][2], v[bj][1][3]);
                    *(u32x4*)(rowp + 32 * bj) = w; }
            }
    }
};
__device__ __forceinline__ float u2f(unsigned u) { return __builtin_bit_cast(float, u); }
__device__ __forceinline__ float bf_lo_f(unsigned u) { return __builtin_bit_cast(float, u << 16); }
__device__ __forceinline__ float bf_hi_f(unsigned u) { return __builtin_bit_cast(float, u & 0xffff0000u); }
template <bool IN32, bool OUT32> struct EpiResT {
    static constexpr bool PERM = true, AFTER_DRAIN = false;
    float* out; bf16_t* xb; float* ss;
    __device__ __forceinline__ void operator()(const f32x4 (&acc)[2][2][4][2], const Unit& u, int wr, int wc, int fr, int fq) const {
        const int row0 = u.pm * BM + wr * 64 + fr; const int colb = u.pn * BM + wc * 32 + 8 * fq;
#pragma unroll
        for (int am = 0; am < 4; ++am) { const int ai = am >> 1, mb = (am & 1) * 2;
            u32x4 bv[2][2][2];
#pragma unroll
            for (int mm = 0; mm < 2; ++mm)
#pragma unroll
                for (int bj = 0; bj < 2; ++bj) { const size_t off = (size_t)(row0 + ai * HALF + (mb + mm) * 16) * 1024 + colb + bj * HALF;
                    bv[mm][bj][0] = *(const u32x4*)(xb + off); bv[mm][bj][1] = bv[mm][bj][0]; }
            asm volatile("" ::: "memory");
#pragma unroll
            for (int mm = 0; mm < 2; ++mm) { const int m = mb + mm;
                const int row = row0 + ai * HALF + m * 16; float q = 0.f;
#pragma unroll
                for (int bj = 0; bj < 2; ++bj) {
                    const size_t off = (size_t)row * 1024 + colb + bj * HALF;
                    float x[8];
                    {
#pragma unroll
                        for (int k = 0; k < 4; ++k) { x[2 * k] = bf_lo_f(bv[mm][bj][0][k]); x[2 * k + 1] = bf_hi_f(bv[mm][bj][0][k]); }
                    }
#pragma unroll
                    for (int k = 0; k < 4; ++k) { x[k] += acc[ai][bj][m][0][k]; x[4 + k] += acc[ai][bj][m][1][k]; }
                    if (OUT32) { *(f32x4*)(out + off) = (f32x4){x[0], x[1], x[2], x[3]}; *(f32x4*)(out + off + 4) = (f32x4){x[4], x[5], x[6], x[7]}; }
                    else {
                        u32x4 h;
#pragma unroll
                        for (int k = 0; k < 4; ++k) h[k] = cvt_pk_bf16(x[2 * k], x[2 * k + 1]);
                        *(u32x4*)(xb + off) = h;
#pragma unroll
                        for (int k = 0; k < 8; ++k) q += x[k] * x[k];
                    }
                }
                if (!OUT32) { q += __shfl_xor(q, 16); q = xor32_add(q, fq); if (fq == 0) ss[(size_t)row * 16 + 4 * u.pn + wc] = q; }
            }
            asm volatile("" ::: "memory");
        }
    }
};
struct EpiGU {
    static constexpr bool PERM = true, AFTER_DRAIN = false;
    bf16_t* H; const float* ss;
    __device__ __forceinline__ void operator()(const f32x4 (&acc)[2][2][4][2], const Unit& u, int wr, int wc, int fr, int fq) const {
        const int row0 = u.pm * BM + wr * 64 + fr;
        float rs[2][4]; row_rstd(ss, row0, fq, rs);
#pragma unroll
        for (int ai = 0; ai < 2; ++ai)
#pragma unroll
            for (int m = 0; m < 4; ++m) {
                const float r = rs[ai][m]; f32x4 h[2];
#pragma unroll
                for (int n = 0; n < 2; ++n) { const f32x4 g = acc[ai][0][m][n] * r, up = acc[ai][1][m][n] * r;
#pragma unroll
                    for (int i = 0; i < 4; ++i) h[n][i] = g[i] * up[i] * __builtin_amdgcn_rcpf(1.0f + __builtin_amdgcn_exp2f(-1.4426950408889634f * g[i])); }
                u32x4 w; w.x = cvt_pk_bf16(h[0][0], h[0][1]); w.y = cvt_pk_bf16(h[0][2], h[0][3]); w.z = cvt_pk_bf16(h[1][0], h[1][1]); w.w = cvt_pk_bf16(h[1][2], h[1][3]);
                *(u32x4*)(H + (size_t)(row0 + ai * HALF + m * 16) * 2816 + u.pn * HALF + wc * 32 + 8 * fq) = w;
            }
    }
};

struct EpiAny {
    static constexpr bool PERM = true, AFTER_DRAIN = false;
    int kind; bf16_t* ob; const float* ss_in; float* ss_out; float* out; const float* qg; const float* kg;
    __device__ __forceinline__ void operator()(const f32x4 (&acc)[2][2][4][2], const Unit& u, int wr, int wc, int fr, int fq) const {
        if (kind == 0) { EpiInProj e{ob, ss_in, qg, kg}; e(acc, u, wr, wc, fr, fq); }
        else if (kind == 1) { EpiResT<false, false> e{out, ob, ss_out}; e(acc, u, wr, wc, fr, fq); }
        else if (kind == 6) { EpiResT<false, true> e{out, ob, ss_out}; e(acc, u, wr, wc, fr, fq); }
        else { EpiGU e{ob, ss_in}; e(acc, u, wr, wc, fr, fq); }
    }
};
template <class Epi, class Sched, bool ALIGN_EPI = false, bool SP2 = false>
__device__ __forceinline__ void gemm_phase(PG8_LAS unsigned char* lds, const Gemm g, const Sched& S, const Epi& E) {
    int tid_ = threadIdx.x; asm volatile("" : "+v"(tid_)); const int tid = tid_, wid = __builtin_amdgcn_readfirstlane(tid >> 6), lane = tid & 63, wr = wid >> 2, wc = wid & 3, fr = lane & 15, fq = lane >> 4;
    const int K = g.K, nt = K / BK;
    unsigned voffA[2], voffB[2];
#pragma unroll
    for (int i = 0; i < 2; ++i) { int R, C; stage_rc(tid * 16 + i * 8192, R, C); const int Rb = Epi::PERM ? ((R & ~31) + perm32(R & 31)) : R;
        voffA[i] = (unsigned)(R * K + C) * 2u; voffB[i] = (unsigned)(Rb * K + C) * 2u; }
    const size_t kstep = (size_t)(BK * 2);
    const size_t hstep = (size_t)HALF * K * 2;
    const size_t tstep = 2 * hstep;
    const unsigned ldsw = (unsigned)wid * 1024u;
    const int aoff = lds_byte(wr * 64 + fr, fq * 8), boff = lds_byte(wc * 32 + fr, fq * 8);
#define PG8_SA(b, h) (((b) * 2 + (h)) * HTB)
#define PG8_SB(b, h) ((4 + (b) * 2 + (h)) * HTB)
#define PG8_STAGE(bufoff, gbase, voff) do { _Pragma("unroll") for (int _i = 0; _i < 2; ++_i) \
        __builtin_amdgcn_global_load_lds((const unsigned*)((const char*)(gbase) + (voff)[_i]), (PG8_LAS unsigned*)(lds + (bufoff) + ldsw + _i * 8192), 16, 0, 0); } while (0)
#define PG8_LDA(dst, b, h) do { _Pragma("unroll") for (int m = 0; m < 4; ++m) _Pragma("unroll") for (int k = 0; k < 2; ++k) dst[m][k] = *(const PG8_LAS bf16x8*)(lds + PG8_SA(b, h) + aoff + m * 2048 + k * 1024); } while (0)
#define PG8_LDB(dst, b, h) do { _Pragma("unroll") for (int n = 0; n < 2; ++n) _Pragma("unroll") for (int k = 0; k < 2; ++k) dst[n][k] = *(const PG8_LAS bf16x8*)(lds + PG8_SB(b, h) + boff + n * 2048 + k * 1024); } while (0)
#define PG8_MMA(ai, bj, At, Bt) do { __builtin_amdgcn_s_setprio(1); _Pragma("unroll") for (int m = 0; m < 4; ++m) _Pragma("unroll") for (int n = 0; n < 2; ++n) _Pragma("unroll") for (int k = 0; k < 2; ++k) \
        acc[ai][bj][m][n] = __builtin_amdgcn_mfma_f32_16x16x32_bf16(Bt[n][k], At[m][k], acc[ai][bj][m][n], 0, 0, 0); __builtin_amdgcn_s_setprio(0); } while (0)
#define PG8_WAIT_V(n) asm volatile("s_waitcnt vmcnt(" #n ")" ::: "memory")
#define PG8_WAIT_L(n) asm volatile("s_waitcnt lgkmcnt(" #n ")" ::: "memory")
#define PG8_BAR __builtin_amdgcn_s_barrier()
#define PG8_SCHED __builtin_amdgcn_sched_barrier(0)
    Unit cur, nxt; int ui = 0;
    if (!S.next(0, cur)) return;
    f32x4 acc[2][2][4][2];
#pragma unroll
    for (int a = 0; a < 2; ++a)
#pragma unroll
        for (int b = 0; b < 2; ++b)
#pragma unroll
            for (int m = 0; m < 4; ++m)
#pragma unroll
                for (int n = 0; n < 2; ++n) acc[a][b][m][n] = (f32x4){0.f, 0.f, 0.f, 0.f};
    bf16x8 At[4][2], B0[2][2], B1[2][2];
    const char* cA = (const char*)g.A + (size_t)cur.pm * tstep; const char* cB = (const char*)g.Bt + (size_t)cur.pn * tstep;
    S.a_ready(cur);
    if constexpr (SP2) {
        PG8_STAGE(PG8_SB(0, 0), cB, voffB); PG8_STAGE(PG8_SB(0, 1), cB + hstep, voffB); PG8_STAGE(PG8_SA(0, 0), cA, voffA); PG8_STAGE(PG8_SA(0, 1), cA + hstep, voffA);
        if (wr == 1) PG8_BAR;
        PG8_WAIT_V(2); PG8_BAR;
        PG8_STAGE(PG8_SB(1, 0), cB + kstep, voffB); PG8_STAGE(PG8_SA(1, 0), cA + kstep, voffA); PG8_STAGE(PG8_SB(1, 1), cB + hstep + kstep, voffB);
        PG8_WAIT_V(6); PG8_BAR;
    } else {
        PG8_STAGE(PG8_SB(0, 0), cB, voffB); PG8_STAGE(PG8_SA(0, 0), cA, voffA); PG8_STAGE(PG8_SB(0, 1), cB + hstep, voffB); PG8_STAGE(PG8_SA(0, 1), cA + hstep, voffA);
        if (wr == 1) PG8_BAR;
        PG8_WAIT_V(4); PG8_BAR;
        PG8_STAGE(PG8_SB(1, 0), cB + kstep, voffB); PG8_STAGE(PG8_SA(1, 0), cA + kstep, voffA); PG8_STAGE(PG8_SB(1, 1), cB + hstep + kstep, voffB);
        PG8_WAIT_V(6); PG8_BAR;
    }
    for (;;) {
        const bool has_next = S.next(ui + 1, nxt);
        const char* nA = has_next ? (const char*)g.A + (size_t)nxt.pm * tstep : cA; const char* nB = has_next ? (const char*)g.Bt + (size_t)nxt.pn * tstep : cB;
        for (int t = 0; t < nt; t += 2) {
            const bool last = (t == nt - 2);
            const char* a1 = cA + (size_t)(t + 1) * kstep;
            const char* a2 = last ? nA : cA + (size_t)(t + 2) * kstep; const char* b2 = last ? nB : cB + (size_t)(t + 2) * kstep;
            const char* a3 = a2 + kstep; const char* b3 = b2 + kstep;
            if (last && has_next) S.a_ready(nxt);
            if constexpr (SP2) {
            PG8_LDB(B0, 0, 0); PG8_LDB(B1, 0, 1); PG8_SCHED; PG8_LDA(At, 0, 0); PG8_STAGE(PG8_SA(1, 1), a1 + hstep, voffA);
            PG8_WAIT_V(8); PG8_WAIT_L(0); PG8_BAR; PG8_MMA(0, 0, At, B0); PG8_MMA(0, 1, At, B1); PG8_BAR; PG8_SCHED;
            PG8_LDA(At, 0, 1); PG8_STAGE(PG8_SB(0, 0), b2, voffB); PG8_STAGE(PG8_SB(0, 1), b2 + hstep, voffB); PG8_STAGE(PG8_SA(0, 0), a2, voffA);
            PG8_WAIT_V(8); PG8_WAIT_L(0); PG8_BAR; PG8_MMA(1, 0, At, B0); PG8_MMA(1, 1, At, B1); PG8_BAR; PG8_SCHED;
            PG8_LDB(B0, 1, 0); PG8_LDB(B1, 1, 1); PG8_SCHED; PG8_LDA(At, 1, 0); PG8_STAGE(PG8_SA(0, 1), a2 + hstep, voffA);
            PG8_WAIT_V(8); PG8_WAIT_L(0); PG8_BAR; PG8_MMA(0, 0, At, B0); PG8_MMA(0, 1, At, B1); PG8_BAR; PG8_SCHED;
            PG8_LDA(At, 1, 1); PG8_STAGE(PG8_SB(1, 0), b3, voffB); PG8_STAGE(PG8_SB(1, 1), b3 + hstep, voffB); PG8_STAGE(PG8_SA(1, 0), a3, voffA);
            PG8_WAIT_V(8); PG8_WAIT_L(0); PG8_BAR; PG8_MMA(1, 0, At, B0); PG8_MMA(1, 1, At, B1); PG8_BAR; PG8_SCHED;
            } else {
            PG8_LDB(B0, 0, 0); PG8_SCHED; PG8_LDA(At, 0, 0); PG8_STAGE(PG8_SA(1, 1), a1 + hstep, voffA);
            PG8_WAIT_L(8); PG8_BAR; PG8_WAIT_L(0); PG8_MMA(0, 0, At, B0); PG8_BAR; PG8_SCHED;
            PG8_LDB(B1, 0, 1); PG8_STAGE(PG8_SB(0, 0), b2, voffB);
            PG8_BAR; PG8_WAIT_L(0); PG8_MMA(0, 1, At, B1); PG8_BAR;
            PG8_LDA(At, 0, 1); PG8_STAGE(PG8_SA(0, 0), a2, voffA);
            PG8_BAR; PG8_WAIT_L(0); PG8_MMA(1, 0, At, B0); PG8_BAR; PG8_SCHED;
            PG8_STAGE(PG8_SB(0, 1), b2 + hstep, voffB);
            PG8_WAIT_V(6); PG8_BAR; PG8_MMA(1, 1, At, B1); PG8_BAR;
            PG8_LDB(B0, 1, 0); PG8_SCHED; PG8_LDA(At, 1, 0); PG8_STAGE(PG8_SA(0, 1), a2 + hstep, voffA);
            PG8_WAIT_L(8); PG8_BAR; PG8_WAIT_L(0); PG8_MMA(0, 0, At, B0); PG8_BAR; PG8_SCHED;
            PG8_LDB(B1, 1, 1); PG8_STAGE(PG8_SB(1, 0), b3, voffB);
            PG8_BAR; PG8_WAIT_L(0); PG8_MMA(0, 1, At, B1); PG8_BAR;
            PG8_LDA(At, 1, 1); PG8_STAGE(PG8_SA(1, 0), a3, voffA);
            PG8_BAR; PG8_WAIT_L(0); PG8_MMA(1, 0, At, B0); PG8_BAR; PG8_SCHED;
            PG8_STAGE(PG8_SB(1, 1), b3 + hstep, voffB);
            PG8_WAIT_V(6); PG8_BAR; PG8_MMA(1, 1, At, B1); PG8_BAR;
            }
        }
        if constexpr (ALIGN_EPI) { if (wr == 0) PG8_BAR; }
        if constexpr (!Epi::AFTER_DRAIN) { E(acc, cur, wr, wc, fr, fq); S.done(cur); }
        if (!has_next) break;
#pragma unroll
        for (int a = 0; a < 2; ++a)
#pragma unroll
            for (int b = 0; b < 2; ++b)
#pragma unroll
                for (int m = 0; m < 4; ++m)
#pragma unroll
                    for (int n = 0; n < 2; ++n) acc[a][b][m][n] = (f32x4){0.f, 0.f, 0.f, 0.f};
        cur = nxt; cA = nA; cB = nB; ++ui;
        if constexpr (ALIGN_EPI) { if (wr == 1) PG8_BAR; }
    }
    PG8_WAIT_V(0);
    if constexpr (!ALIGN_EPI) { if (wr == 0) PG8_BAR; }
    PG8_BAR;
    if constexpr (Epi::AFTER_DRAIN) { E.fused(acc, cur, wr, wc, fr, fq, lds, wid, lane); S.done(cur); }
#undef PG8_SA
#undef PG8_SB
#undef PG8_STAGE
#undef PG8_LDA
#undef PG8_LDB
#undef PG8_MMA
#undef PG8_WAIT_V
#undef PG8_WAIT_L
#undef PG8_BAR
#undef PG8_SCHED
}
}

#ifndef MK_ONE_LAUNCH
#define MK_ONE_LAUNCH 1
#endif
constexpr int NWAVES = 8, NTHREADS = 512;
constexpr int DM = 1024, NB = 32, SEQ = 2048, DEPTH = 4, M_TOK = NB * SEQ;
constexpr int INC = 2304, FFH = 2816, NHEAD = 8;
constexpr int N_PHASES = 1 + 5 * DEPTH;
constexpr size_t MiB = 1u << 20;
constexpr size_t WS_WIN = 0;
constexpr size_t WS_WOUT = 18 * MiB;
constexpr size_t WS_WGU = 26 * MiB;
constexpr size_t WS_WDN = 70 * MiB;
constexpr size_t WS_WPW = 92 * MiB;
constexpr size_t WS_SS = 93 * MiB;
constexpr size_t WS_XB = 98 * MiB;
constexpr size_t WS_PROJ = 226 * MiB;
constexpr size_t WS_MIX = 514 * MiB;
constexpr size_t WS_HID = WS_PROJ;
constexpr size_t WS_END = 642 * MiB;
constexpr int LDS_BYTES = 147456;

#define LAS __attribute__((address_space(3)))
typedef unsigned short bf16;
typedef unsigned u32x4 __attribute__((ext_vector_type(4)));
typedef unsigned u32x2 __attribute__((ext_vector_type(2)));
typedef float f32x4 __attribute__((ext_vector_type(4)));
typedef float f32x16 __attribute__((ext_vector_type(16)));
typedef short bf16x8 __attribute__((ext_vector_type(8)));
typedef short s16x4 __attribute__((ext_vector_type(4)));

typedef float f32x2_t __attribute__((ext_vector_type(2))); typedef __bf16 bf16x2_t __attribute__((ext_vector_type(2)));
__device__ __forceinline__ unsigned pk2(float lo, float hi) { const f32x2_t v = {lo, hi}; const bf16x2_t b = __builtin_convertvector(v, bf16x2_t); return __builtin_bit_cast(unsigned, b); }
__device__ __forceinline__ float bflo(unsigned u) { return __builtin_bit_cast(float, u << 16); }
__device__ __forceinline__ float bfhi(unsigned u) { return __builtin_bit_cast(float, u & 0xffff0000u); }
__device__ __forceinline__ float wave_sum(float v) {
#pragma unroll
    for (int o = 1; o < 64; o <<= 1) v += __shfl_xor(v, o);
    return v;
}
__device__ __forceinline__ int tid_opaque() { int t = threadIdx.x; asm volatile("" : "+v"(t)); return t; }
__device__ __forceinline__ int crow(int r, int hi) { return (r & 3) + 8 * (r >> 2) + 4 * hi; }
__device__ __forceinline__ float sigmoidf_(float x) { return __builtin_amdgcn_rcpf(1.0f + __builtin_amdgcn_exp2f(-1.4426950408889634f * x)); }

constexpr int PT_OFF = 147200;
template <class T> __device__ __forceinline__ T* ldp(LAS unsigned char* lds, int k) {
    const unsigned long long v = ((const volatile LAS unsigned long long*)(lds + PT_OFF))[k];
    const unsigned lo = __builtin_amdgcn_readfirstlane((unsigned)v), hi = __builtin_amdgcn_readfirstlane((unsigned)(v >> 32));
    return (T*)(((unsigned long long)hi << 32) | lo);
}
#define PIN(k) ldp<const float>(lds, (k))
struct Args { const float* in[16]; float* out; unsigned char* ws; int ph_lo, ph_hi; };

typedef __attribute__((address_space(1))) unsigned gu32;
#define XB_TMO      128
#define XB_XCNT(j)  (256  + 64 * (j))
#define XB_XSUB(j)  (1280 + 64 * (j))
#define XB_XGEN(j)  (2304 + 64 * (j))
#define XB_TOP      3328
#define XB_TOPGEN   3392
#define XCD_BAR_WORDS 3456
#define XB_SPIN_CAP (1u << 18)

__device__ __forceinline__ unsigned xb_ld(unsigned* p)              { return __hip_atomic_load(p, __ATOMIC_RELAXED, __HIP_MEMORY_SCOPE_AGENT); }
__device__ __forceinline__ unsigned xb_add(unsigned* p, unsigned v) { return __hip_atomic_fetch_add(p, v, __ATOMIC_RELAXED, __HIP_MEMORY_SCOPE_AGENT); }
__device__ __forceinline__ unsigned xb_xcc_id() { return (unsigned)__builtin_amdgcn_s_getreg((3 << 11) | 20) & 0xFu; }
#define XB_SPIN(cond, bar) do { unsigned _sp = 0; while (cond) { __builtin_amdgcn_s_sleep(1); \
    if ((++_sp & 255u) == 0u) { if (xb_ld(&(bar)[XB_TMO])) break; if (_sp > XB_SPIN_CAP) { atomicAdd(&(bar)[XB_TMO], 1u); break; } } } } while (0)

struct XcdBarrier {
    unsigned* bar; unsigned x;
    volatile LAS unsigned* st;
};

__device__ __forceinline__ XcdBarrier xcd_barrier_post(unsigned* bar, volatile LAS unsigned* st) {
    XcdBarrier b; b.bar = bar; b.x = xb_xcc_id(); b.st = st;
    if (threadIdx.x == 0) (void)xb_add(&bar[XB_XCNT(b.x)], 1u);
    return b;
}
__device__ __forceinline__ void xcd_barrier_complete(unsigned* bar, unsigned x, unsigned& nloc, unsigned& nx) {
    const unsigned G = gridDim.x * gridDim.y * gridDim.z;
    unsigned sum, cnt, mine, sp = 0u;
    for (;;) {
        sum = 0u; cnt = 0u; mine = 0u;
#pragma unroll
        for (unsigned j = 0; j < 16; ++j) { const unsigned c = xb_ld(&bar[XB_XCNT(j)]); sum += c; cnt += (c > 0u) ? 1u : 0u; mine = (j == x) ? c : mine; }
        if (sum == G) break;
        __builtin_amdgcn_s_sleep(1);
        if ((++sp & 255u) == 0u) { if (xb_ld(&bar[XB_TMO])) break; if (sp > XB_SPIN_CAP) { atomicAdd(&bar[XB_TMO], 1u); break; } }
    }
    nloc = mine > 0u ? mine : 1u; nx = cnt > 0u ? cnt : 1u;
}

__device__ __forceinline__ void xcd_barrier(const XcdBarrier& b) {
    asm volatile("s_waitcnt vmcnt(0)" ::: "memory");
    __syncthreads();
    if (threadIdx.x == 0) {
        unsigned* bar = b.bar;
        __builtin_amdgcn_s_waitcnt(0);
        unsigned nloc = b.st[0], nx = b.st[1];
        if (nloc == 0u) { xcd_barrier_complete(bar, b.x, nloc, nx); b.st[0] = nloc; b.st[1] = nx; }
        const unsigned old = xb_add(&bar[XB_XSUB(b.x)], 1u);
        const unsigned gen = old / nloc;
        if (old + 1u == (gen + 1u) * nloc) {
            __builtin_amdgcn_fence(__ATOMIC_RELEASE, "agent");
            asm volatile("s_waitcnt vmcnt(0)" ::: "memory");
            const unsigned og = xb_add(&bar[XB_TOP], 1u);
            const unsigned tg = og / nx;
            if (og + 1u == (tg + 1u) * nx) xb_add(&bar[XB_TOPGEN], 1u);
            else XB_SPIN(xb_ld(&bar[XB_TOPGEN]) == tg, bar);
            __builtin_amdgcn_fence(__ATOMIC_ACQUIRE, "agent");
            xb_add(&bar[XB_XGEN(b.x)], 1u);
            asm volatile("s_waitcnt vmcnt(0)" ::: "memory");
        } else {
            XB_SPIN(xb_ld(&bar[XB_XGEN(b.x)]) == gen, bar);
            __builtin_amdgcn_fence(__ATOMIC_ACQUIRE, "agent");
            asm volatile("s_waitcnt vmcnt(0)" ::: "memory");
        }
    }
    __syncthreads();
}

constexpr size_t WS_BAR = 97 * MiB;
constexpr int BST_OFF = PT_OFF + 192;

__device__ __forceinline__ void tr64_fill(const float* W, int N, const float* s, int k0, int srcA, int srcB, LAS float* scr, int lane) {
    const int col4 = (lane & 15) * 4, src = col4 < 32 ? srcA + col4 : srcB + col4 - 32;
    f32x4 v[16];
#pragma unroll
    for (int i = 0; i < 16; ++i) v[i] = *(const f32x4*)(W + (size_t)(k0 + 4 * i + (lane >> 4)) * N + src);
#pragma unroll
    for (int i = 0; i < 16; ++i) { const int kk = 4 * i + (lane >> 4); const float sc = s ? s[k0 + kk] : 1.0f; LAS float* p = scr + kk * 65 + col4;
        p[0] = v[i][0] * sc; p[1] = v[i][1] * sc; p[2] = v[i][2] * sc; p[3] = v[i][3] * sc; }
}
__device__ __forceinline__ void tr64_flush(bf16* WT, int K, int k0, int dstA, int dstB, LAS float* scr, int lane) {
    asm volatile("s_waitcnt lgkmcnt(0)" ::: "memory");
    const int c = lane & 7;
#pragma unroll
    for (int j = 0; j < 8; ++j) { const int n = (lane >> 3) + 8 * j, row = n < 32 ? dstA + n : dstB + n - 32; const LAS float* p = scr + (8 * c) * 65 + n;
        u32x4 o; o.x = pk2(p[0 * 65], p[1 * 65]); o.y = pk2(p[2 * 65], p[3 * 65]); o.z = pk2(p[4 * 65], p[5 * 65]); o.w = pk2(p[6 * 65], p[7 * 65]);
        *(u32x4*)(WT + (size_t)row * K + k0 + 8 * c) = o; }
    asm volatile("s_waitcnt lgkmcnt(0)" ::: "memory");
}
__device__ __forceinline__ void pool_fill(const float* Win, const float* ng, const float* pw, const float* psc, int k0, int g, LAS float* scr, int lane) {
    float pc[64]; const float sc = psc[64 * g + lane];
#pragma unroll
    for (int i = 0; i < 64; ++i) pc[i] = pw[(size_t)(g * 64 + i) * 64 + lane] * sc;
    for (int kb = 0; kb < 64; kb += 4) {
        float wv[4];
#pragma unroll
        for (int q = 0; q < 4; ++q) wv[q] = Win[(size_t)(k0 + kb + q) * INC + 1536 + 64 * g + lane] * ng[k0 + kb + q];
#pragma unroll
        for (int q = 0; q < 4; ++q) { float acc = 0.f;
#pragma unroll
            for (int i = 0; i < 64; ++i) acc += __builtin_bit_cast(float, __builtin_amdgcn_readlane(__builtin_bit_cast(int, wv[q]), i)) * pc[i];
            scr[(kb + q) * 65 + lane] = acc; }
    }
}
__device__ __forceinline__ void p0_prologue(LAS unsigned char* lds, int G, int bid) {
    const int tid = tid_opaque(), lane = tid & 63, wave = __builtin_amdgcn_readfirstlane(tid >> 6);
    LAS float* scr = (LAS float*)(lds + wave * 16640);
    const int gw = bid * NWAVES + wave, NGW = G * NWAVES;
    unsigned char* ws = ldp<unsigned char>(lds, 17);
    constexpr int I_IN = 16 * 36, I_OUT = 16 * 16, I_GU = 16 * 88, I_DN = 44 * 16, I_PW = 4 * 4, I_L = I_IN + I_OUT + I_GU + I_DN + I_PW;
    for (int it = gw; it < DEPTH * I_L; it += NGW) {
        const int l = it / I_L; int r = it % I_L;
        if (r < I_IN) { const int kb = r / 36, nb = r % 36; const int nd = 64 * nb, pn = nd >> 8, bj = (nd >> 7) & 1, h2 = (nd >> 6) & 1;
            bf16* WT = (bf16*)(ws + WS_WIN) + (size_t)l * INC * DM;
            if (pn != 6) { const int sA = pn >= 7 ? 1792 + 256 * bj + 128 * (pn - 7) + 64 * h2 : 256 * pn + 128 * h2 + 32 * bj, sB = pn >= 7 ? sA + 32 : sA + 64;
                tr64_fill(PIN(2) + (size_t)l * DM * INC, INC, PIN(1) + l * DM, 64 * kb, sA, sB, scr, lane); tr64_flush(WT, DM, 64 * kb, nd, nd + 32, scr, lane); }
            else { const int g = nb - 24; pool_fill(PIN(2) + (size_t)l * DM * INC, PIN(1) + l * DM, PIN(5) + (size_t)l * 4 * 64 * 64, PIN(6) + l * 256, 64 * kb, g, scr, lane); tr64_flush(WT, DM, 64 * kb, 1536 + 32 * g, 1536 + 128 + 32 * g, scr, lane); }
            continue; }
        r -= I_IN;
        if (r < I_OUT) { const int kb = r / 16, nd = 64 * (r % 16); tr64_fill(PIN(12) + (size_t)l * DM * DM, DM, nullptr, 64 * kb, nd, nd + 32, scr, lane); tr64_flush((bf16*)(ws + WS_WOUT) + (size_t)l * DM * DM, DM, 64 * kb, nd, nd + 32, scr, lane); continue; }
        r -= I_OUT;
        if (r < I_GU) { const int kb = r / 88, nd = 64 * (r % 88); const int pn = nd >> 8, bj = (nd >> 7) & 1, q2 = (nd >> 6) & 1, src = bj * FFH + 128 * pn + 64 * q2;
            tr64_fill(PIN(14) + (size_t)l * DM * 2 * FFH, 2 * FFH, PIN(13) + l * DM, 64 * kb, src, src + 32, scr, lane); tr64_flush((bf16*)(ws + WS_WGU) + (size_t)l * 2 * FFH * DM, DM, 64 * kb, nd, nd + 32, scr, lane); continue; }
        r -= I_GU;
        if (r < I_DN) { const int kb = r / 16, nd = 64 * (r % 16); tr64_fill(PIN(15) + (size_t)l * FFH * DM, DM, nullptr, 64 * kb, nd, nd + 32, scr, lane); tr64_flush((bf16*)(ws + WS_WDN) + (size_t)l * DM * FFH, FFH, 64 * kb, nd, nd + 32, scr, lane); continue; }
        r -= I_DN;
        { const int kb = r / 4, nd = 64 * (r % 4); tr64_fill(PIN(11) + (size_t)l * 256 * 256, 256, nullptr, 64 * kb, nd, nd + 32, scr, lane); tr64_flush((bf16*)(ws + WS_WPW) + (size_t)l * 256 * 256, 256, 64 * kb, nd, nd + 32, scr, lane); }
    }
    const float* x = PIN(0); bf16* xb = (bf16*)(ws + WS_XB); float* ss = (float*)(ws + WS_SS);
    for (int m = 4 * gw; m < M_TOK; m += 4 * NGW) {
        f32x4 v[4][4]; float s[4];
#pragma unroll
        for (int q = 0; q < 4; ++q)
#pragma unroll
            for (int j = 0; j < 4; ++j) v[q][j] = ((const f32x4*)(x + (size_t)(m + q) * DM) + lane)[64 * j];
#pragma unroll
        for (int q = 0; q < 4; ++q) { s[q] = 0.f;
#pragma unroll
            for (int j = 0; j < 4; ++j) s[q] += (v[q][j][0] * v[q][j][0] + v[q][j][1] * v[q][j][1]) + (v[q][j][2] * v[q][j][2] + v[q][j][3] * v[q][j][3]); }
#pragma unroll
        for (int q = 0; q < 4; ++q) s[q] = wave_sum(s[q]);
#pragma unroll
        for (int q = 0; q < 4; ++q) {
            u32x2* o8 = (u32x2*)(xb + (size_t)(m + q) * DM) + lane;
#pragma unroll
            for (int j = 0; j < 4; ++j) { u32x2 w; w.x = pk2(v[q][j][0], v[q][j][1]); w.y = pk2(v[q][j][2], v[q][j][3]); o8[64 * j] = w; }
            if (lane < 16) ss[(size_t)(m + q) * 16 + lane] = lane == 0 ? s[q] : 0.f; }
    }
}

constexpr int AT_K0 = 0, AT_V0 = 8192, AT_BUF = 16384, AT_FLAGS = 32768;
__device__ __forceinline__ f32x16 at_qk(const LAS unsigned char* kb, const bf16x8 (&qr)[4]) {
    f32x16 s = {};
#pragma unroll
    for (int d0 = 0; d0 < 4; ++d0) { const bf16x8 kf = *(const LAS bf16x8*)(kb + d0 * 2048); s = __builtin_amdgcn_mfma_f32_32x32x16_bf16(kf, qr[d0], s, 0, 0, 0); }
    return s;
}
__device__ __forceinline__ void at_sb(const f32x16& s, bool diag, int r32, int hi, float& carry, u32x4& pa0, u32x4& pa1) {
    float E[16], uu[16], wv[16];
#pragma unroll
    for (int r = 0; r < 16; ++r) { E[r] = __builtin_amdgcn_exp2f(s[r]); uu[r] = 1.0f + E[r]; }
    if (diag) {
#pragma unroll
        for (int r = 0; r < 16; ++r) { const bool valid = crow(r, hi) < r32; uu[r] = valid ? uu[r] : 1.0f; E[r] = valid ? E[r] : 0.0f; }
    }
    float g[4], og[4];
#pragma unroll
    for (int bq = 0; bq < 4; ++bq)
        g[bq] = __builtin_amdgcn_rcpf(((uu[4 * bq + 3] * uu[4 * bq + 2]) * uu[4 * bq + 1]) * uu[4 * bq + 0]);
#pragma unroll
    for (int bq = 0; bq < 4; ++bq) {
        const unsigned own = __builtin_bit_cast(unsigned, g[bq]);
        const auto sw = __builtin_amdgcn_permlane32_swap(own, own, false, false);
        og[bq] = __builtin_bit_cast(float, hi ? sw[0] : sw[1]);
    }
    float pre = carry;
#pragma unroll
    for (int bq = 3; bq >= 0; --bq) {
        const float mine = hi ? pre : pre * og[bq];
        const float i0 = g[bq] * mine, i1 = i0 * uu[4 * bq + 0], i2 = i1 * uu[4 * bq + 1], i3 = i2 * uu[4 * bq + 2];
        wv[4 * bq + 0] = E[4 * bq + 0] * i0; wv[4 * bq + 1] = E[4 * bq + 1] * i1; wv[4 * bq + 2] = E[4 * bq + 2] * i2; wv[4 * bq + 3] = E[4 * bq + 3] * i3;
        pre *= g[bq] * og[bq];
    }
    carry = pre;
    pa0.x = pk2(wv[0], wv[1]); pa0.y = pk2(wv[2], wv[3]); pa0.z = pk2(wv[4], wv[5]); pa0.w = pk2(wv[6], wv[7]);
    pa1.x = pk2(wv[8], wv[9]); pa1.y = pk2(wv[10], wv[11]); pa1.z = pk2(wv[12], wv[13]); pa1.w = pk2(wv[14], wv[15]);
}
__device__ __forceinline__ void at_pv(const LAS unsigned char* vbase, int p, const u32x4& pa0, const u32x4& pa1, f32x16& o0, f32x16& o1) {
#pragma unroll
    for (int sq = 0; sq < 2; ++sq) {
        const bf16x8 pa = __builtin_bit_cast(bf16x8, sq ? pa1 : pa0); const int ks = 2 * p + sq;
#pragma unroll
        for (int d0 = 0; d0 < 2; ++d0) {
            const s16x4 lo = __builtin_bit_cast(s16x4, __builtin_amdgcn_ds_read_tr16_b64_v4i16((LAS s16x4*)(vbase + d0 * 4096 + ks * 1024)));
            const s16x4 hh = __builtin_bit_cast(s16x4, __builtin_amdgcn_ds_read_tr16_b64_v4i16((LAS s16x4*)(vbase + d0 * 4096 + ks * 1024 + 512)));
            const bf16x8 vf = (bf16x8){lo[0], lo[1], lo[2], lo[3], hh[0], hh[1], hh[2], hh[3]};
            if (d0 == 0) o0 = __builtin_amdgcn_mfma_f32_32x32x16_bf16(pa, vf, o0, 0, 0, 0); else o1 = __builtin_amdgcn_mfma_f32_32x32x16_bf16(pa, vf, o1, 0, 0, 0);
        }
    }
}
__device__ __forceinline__ void attn_phase(LAS unsigned char* lds, const bf16* proj, bf16* mix, int G, int bid) {
    const int tid = tid_opaque(), lane = tid & 63, r32 = lane & 31, hi = lane >> 5, wid = __builtin_amdgcn_readfirstlane(tid >> 6);
    bf16x8 qn[4]; u32x4 kn = {}, vn = {};
    if (bid < NB * NHEAD * 8) { const int bh = bid & 255, qb = 7 - (bid >> 8), b = bh >> 3, h = bh & 7; const size_t rowbase = (size_t)b * SEQ; const int nt = 4 * qb + 4;
#pragma unroll
        for (int d0 = 0; d0 < 4; ++d0) qn[d0] = *(const bf16x8*)(proj + (rowbase + qb * 256 + wid * 32 + r32) * INC + h * 64 + d0 * 16 + hi * 8);
        kn = *(const u32x4*)(proj + rowbase * INC + 512 + h * 64 + (size_t)lane * INC + wid * 8 + (size_t)(nt - 1) * 64 * INC);
        vn = *(const u32x4*)(proj + rowbase * INC + 1024 + h * 64 + (size_t)(16 * (wid & 3) + (lane >> 2)) * INC + (wid >> 2) * 32 + (lane & 3) * 8 + (size_t)(nt - 1) * 64 * INC); }
    for (int u = bid; u < NB * NHEAD * 8; u += G) {
        const int bh = u & 255, qb = 7 - (u >> 8), b = bh >> 3, h = bh & 7;
        const size_t rowbase = (size_t)b * SEQ; const int q0 = qb * 256, Q0 = q0 + wid * 32;
        const bf16* Kp = proj + rowbase * INC + 512 + h * 64 + (size_t)lane * INC + wid * 8;
        const bf16* Vp = proj + rowbase * INC + 1024 + h * 64 + (size_t)(16 * (wid & 3) + (lane >> 2)) * INC + (wid >> 2) * 32 + (lane & 3) * 8;
        bf16x8 qr[4];
#pragma unroll
        for (int d0 = 0; d0 < 4; ++d0) qr[d0] = qn[d0];
        const int nt = 4 * qb + 4;
        u32x4 kreg = kn, vreg = vn;
        if (u + G < NB * NHEAD * 8) { const int u2 = u + G, bh2 = u2 & 255, qb2 = 7 - (u2 >> 8), b2 = bh2 >> 3, h2 = bh2 & 7; const size_t rb2 = (size_t)b2 * SEQ; const int nt2 = 4 * qb2 + 4;
#pragma unroll
            for (int d0 = 0; d0 < 4; ++d0) qn[d0] = *(const bf16x8*)(proj + (rb2 + qb2 * 256 + wid * 32 + r32) * INC + h2 * 64 + d0 * 16 + hi * 8);
            kn = *(const u32x4*)(proj + rb2 * INC + 512 + h2 * 64 + (size_t)lane * INC + wid * 8 + (size_t)(nt2 - 1) * 64 * INC);
            vn = *(const u32x4*)(proj + rb2 * INC + 1024 + h2 * 64 + (size_t)(16 * (wid & 3) + (lane >> 2)) * INC + (wid >> 2) * 32 + (lane & 3) * 8 + (size_t)(nt2 - 1) * 64 * INC); }
        __syncthreads();
        *(LAS u32x4*)(lds + AT_K0 + wid * 1024 + lane * 16) = kreg; *(LAS u32x4*)(lds + AT_V0 + wid * 1024 + lane * 16) = vreg;
        kreg = *(const u32x4*)(Kp + (size_t)(nt - 2) * 64 * INC); vreg = *(const u32x4*)(Vp + (size_t)(nt - 2) * 64 * INC);
        float carry = 1.0f; f32x16 o0 = {}, o1 = {};
        int cur = 0;
        for (int j = nt - 1; j >= 0; --j) {
            __syncthreads();
            if (j < nt - 1) {
                const LAS unsigned* fl = (const LAS unsigned*)(lds + AT_FLAGS) + ((j + 1) & 1) * 8;
                const u32x4 f0 = *(const LAS u32x4*)fl, f1 = *(const LAS u32x4*)(fl + 4);
                const unsigned alld = (f0[0] & f0[1] & f0[2] & f0[3]) & (f1[0] & f1[1] & f1[2] & f1[3]);
                if (__builtin_amdgcn_readfirstlane(alld) != 0u) break;
            }
            if (j > 0) { *(LAS u32x4*)(lds + (cur ^ 1) * AT_BUF + AT_K0 + wid * 1024 + lane * 16) = kreg; *(LAS u32x4*)(lds + (cur ^ 1) * AT_BUF + AT_V0 + wid * 1024 + lane * 16) = vreg; }
            if (j > 1) { kreg = *(const u32x4*)(Kp + (size_t)(j - 2) * 64 * INC); vreg = *(const u32x4*)(Vp + (size_t)(j - 2) * 64 * INC); }
            const LAS unsigned char* kbase = lds + cur * AT_BUF + AT_K0 + hi * 1024 + r32 * 16;
            const LAS unsigned char* vbase = lds + cur * AT_BUF + AT_V0 + ((lane >> 4) & 1) * 32 + (lane & 3) * 8 + (4 * hi + ((lane & 15) >> 2)) * 64;
            u32x4 pa0, pa1;
            if (__all(carry == 0.0f)) {   }
            else if (64 * j + 32 < Q0) {
                const f32x16 s1 = at_qk(kbase + 512, qr), s0 = at_qk(kbase, qr);
                at_sb(s1, false, r32, hi, carry, pa0, pa1); at_pv(vbase, 1, pa0, pa1, o0, o1);
                at_sb(s0, false, r32, hi, carry, pa0, pa1); at_pv(vbase, 0, pa0, pa1, o0, o1);
            } else {
#pragma unroll
                for (int pp = 0; pp < 2; ++pp) {
                    const int p = 1 - pp, s0i = 64 * j + 32 * p;
                    if (s0i > Q0) continue;
                    const f32x16 s = at_qk(kbase + p * 512, qr);
                    at_sb(s, s0i == Q0, r32, hi, carry, pa0, pa1); at_pv(vbase, p, pa0, pa1, o0, o1);
                }
            }
            { const unsigned dn = __all(carry == 0.0f) ? 1u : 0u;
              if (lane == 0) ((LAS unsigned*)(lds + AT_FLAGS))[(j & 1) * 8 + wid] = dn; }
            cur ^= 1;
        }
        bf16* Op = mix + (rowbase + Q0) * DM + h * 64 + r32;
#pragma unroll
        for (int r = 0; r < 16; ++r) { bf16* p = Op + (size_t)crow(r, hi) * DM; p[0] = (bf16)(pk2(o0[r], 0.f) & 0xffffu); p[32] = (bf16)(pk2(o1[r], 0.f) & 0xffffu); }
    }
}

__device__ __forceinline__ void unpk8(const u32x4 v, float (&f)[8]) { f[0] = bflo(v.x); f[1] = bfhi(v.x); f[2] = bflo(v.y); f[3] = bfhi(v.y); f[4] = bflo(v.z); f[5] = bfhi(v.z); f[6] = bflo(v.w); f[7] = bfhi(v.w); }
template <int W> __device__ __forceinline__ void pool_item(const bf16* proj, bf16* mix, int tok0, int c) {
    const int t0 = tok0 & (SEQ - 1);
    u32x4 raw[W + 3];
#pragma unroll
    for (int r = 0; r < W + 3; ++r) { const int dt = r - (W - 1); raw[r] = (u32x4){0u, 0u, 0u, 0u}; if (t0 + dt >= 0) raw[r] = *(const u32x4*)(proj + (size_t)(tok0 + dt) * INC + 1536 + c); }
    float s[8], f[8];
#pragma unroll
    for (int k = 0; k < 8; ++k) s[k] = 0.f;
#pragma unroll
    for (int r = 0; r < W; ++r) { unpk8(raw[r], f);
#pragma unroll
        for (int k = 0; k < 8; ++k) s[k] += f[k]; }
#pragma unroll
    for (int i = 0; i < 4; ++i) {
        float m0[8]; unpk8(raw[W - 1 + i], m0);
        if (i > 0) { unpk8(raw[i - 1], f);
#pragma unroll
            for (int k = 0; k < 8; ++k) s[k] += m0[k] - f[k]; }
        const int cnt = (t0 + i + 1) < W ? (t0 + i + 1) : W; const float inv = 1.0f / (float)cnt;
        u32x4 o; o.x = pk2(s[0] * inv - m0[0], s[1] * inv - m0[1]); o.y = pk2(s[2] * inv - m0[2], s[3] * inv - m0[3]); o.z = pk2(s[4] * inv - m0[4], s[5] * inv - m0[5]); o.w = pk2(s[6] * inv - m0[6], s[7] * inv - m0[7]);
        *(u32x4*)(mix + (size_t)(tok0 + i) * DM + 512 + c) = o;
    }
}
__device__ __forceinline__ void pool_phase(const bf16* proj, bf16* mix, int G, int bid) {
    const int tid = tid_opaque(), lane = tid & 63, wave = tid >> 6;
    for (int wi = bid * NWAVES + wave; wi < 4 * (M_TOK / 32); wi += G * NWAVES) {
        const int g = wi & 3, tok0 = ((wi >> 2) * 8 + (lane >> 3)) * 4, c = 64 * g + 8 * (lane & 7);
        if (g == 0) pool_item<2>(proj, mix, tok0, c); else if (g == 1) pool_item<4>(proj, mix, tok0, c); else if (g == 2) pool_item<8>(proj, mix, tok0, c); else pool_item<16>(proj, mix, tok0, c);
    }
}

constexpr int CV_ROWS = 94, CV_AB = CV_ROWS * 256 * 4  , CV_APITCH = 528;
__device__ __forceinline__ void conv_phase(LAS unsigned char* lds, const bf16* proj, bf16* mix, const float* cw, const float* cb, const float* lng, const float* lnb, const bf16* pwT, int G, int bid) {
    LAS float* hb = (LAS float*)lds; LAS unsigned char* ab = lds + CV_AB;
    const int tid = tid_opaque(), lane = tid & 63, r32 = lane & 31, hi = lane >> 5, wid = __builtin_amdgcn_readfirstlane(tid >> 6);
    const int c = tid & 255, half = tid >> 8;
    if (bid >= M_TOK / 64) return;
    bf16x8 pwf[16];
#pragma unroll
    for (int kk = 0; kk < 16; ++kk) pwf[kk] = *(const bf16x8*)(pwT + (size_t)(32 * wid + r32) * 256 + 16 * kk + 8 * hi);
    float w[31];
#pragma unroll
    for (int j = 0; j < 31; ++j) w[j] = cw[j * 256 + c];
    const float bias = cb[c];
    const f32x4 gg = *(const f32x4*)(lng + 4 * lane), bb = *(const f32x4*)(lnb + 4 * lane);
    for (int tile = bid; tile < M_TOK / 64; tile += G) {
        const int tok0 = tile * 64, t0 = tok0 & (SEQ - 1);
        u32x4 av[6];
#pragma unroll
        for (int k = 0; k < 6; ++k) { const int it = tid + NTHREADS * k, i = it >> 5, c8 = (it & 31) * 8; av[k] = (u32x4){0u, 0u, 0u, 0u};
            if (it < CV_ROWS * 32 && t0 - 30 + i >= 0) av[k] = *(const u32x4*)(proj + (size_t)(tok0 - 30 + i) * INC + 1792 + c8); }
        __syncthreads();
#pragma unroll
        for (int k = 0; k < 6; ++k) { const int it = tid + NTHREADS * k, i = it >> 5, c8 = (it & 31) * 8;
            if (it < CV_ROWS * 32) { float a8[8]; unpk8(av[k], a8);
                *(LAS f32x4*)(hb + i * 256 + c8) = (f32x4){a8[0], a8[1], a8[2], a8[3]}; *(LAS f32x4*)(hb + i * 256 + c8 + 4) = (f32x4){a8[4], a8[5], a8[6], a8[7]}; } }
        __syncthreads();
        float in[62];
#pragma unroll
        for (int i = 0; i < 62; ++i) in[i] = hb[(32 * half + i) * 256 + c];
        __syncthreads();
#pragma unroll
        for (int t = 0; t < 32; ++t) { float acc = bias;
#pragma unroll
            for (int j = 0; j < 31; ++j) acc += w[j] * in[t + j];
            hb[(32 * half + t) * 256 + c] = acc; }
        __syncthreads();
#pragma unroll
        for (int tt = 0; tt < 8; ++tt) { const int tk = 8 * wid + tt; const f32x4 v = *(const LAS f32x4*)(hb + tk * 256 + 4 * lane);
            const float mean = wave_sum((v[0] + v[1]) + (v[2] + v[3])) * (1.0f / 256.0f); const f32x4 d = v - mean;
            const float var = wave_sum((d[0] * d[0] + d[1] * d[1]) + (d[2] * d[2] + d[3] * d[3])) * (1.0f / 256.0f); const float rstd = __builtin_amdgcn_rsqf(var + 1e-5f);
            f32x4 y = d * rstd * gg + bb;
#pragma unroll
            for (int i = 0; i < 4; ++i) y[i] = y[i] * sigmoidf_(y[i]);
            u32x2 o; o.x = pk2(y[0], y[1]); o.y = pk2(y[2], y[3]); *(LAS u32x2*)(ab + tk * CV_APITCH + lane * 8) = o; }
        __syncthreads();
        f32x16 a0 = {}, a1 = {};
#pragma unroll
        for (int kk = 0; kk < 16; ++kk) {
            const bf16x8 f0 = *(const LAS bf16x8*)(ab + r32 * CV_APITCH + (16 * kk + 8 * hi) * 2), f1 = *(const LAS bf16x8*)(ab + (r32 + 32) * CV_APITCH + (16 * kk + 8 * hi) * 2);
            a0 = __builtin_amdgcn_mfma_f32_32x32x16_bf16(f0, pwf[kk], a0, 0, 0, 0); a1 = __builtin_amdgcn_mfma_f32_32x32x16_bf16(f1, pwf[kk], a1, 0, 0, 0);
        }
        bf16* Op = mix + (size_t)tok0 * DM + 768 + 32 * wid + r32;
#pragma unroll
        for (int r = 0; r < 16; ++r) { Op[(size_t)crow(r, hi) * DM] = (bf16)(pk2(a0[r], 0.f) & 0xffffu); Op[(size_t)(crow(r, hi) + 32) * DM] = (bf16)(pk2(a1[r], 0.f) & 0xffffu); }
    }
}

__global__ void __launch_bounds__(NTHREADS, 2) mk_fwd(Args a) {
    extern __shared__ __attribute__((aligned(16))) unsigned char lds_raw[];
    LAS unsigned char* lds = (LAS unsigned char*)lds_raw;
    const int G = gridDim.x, bid = blockIdx.x;
    if (threadIdx.x == 0) { LAS unsigned long long* PT = (LAS unsigned long long*)(lds + PT_OFF);
        PT[0] = (unsigned long long)a.in[0]; PT[1] = (unsigned long long)a.in[1]; PT[2] = (unsigned long long)a.in[2]; PT[3] = (unsigned long long)a.in[3];
        PT[4] = (unsigned long long)a.in[4]; PT[5] = (unsigned long long)a.in[5]; PT[6] = (unsigned long long)a.in[6]; PT[7] = (unsigned long long)a.in[7];
        PT[8] = (unsigned long long)a.in[8]; PT[9] = (unsigned long long)a.in[9]; PT[10] = (unsigned long long)a.in[10]; PT[11] = (unsigned long long)a.in[11];
        PT[12] = (unsigned long long)a.in[12]; PT[13] = (unsigned long long)a.in[13]; PT[14] = (unsigned long long)a.in[14]; PT[15] = (unsigned long long)a.in[15];
        PT[16] = (unsigned long long)a.out; PT[17] = (unsigned long long)a.ws; }
    if (threadIdx.x == 0) { ((volatile LAS unsigned*)(lds + BST_OFF))[0] = 0u; ((volatile LAS unsigned*)(lds + BST_OFF))[1] = 0u; }
    const int ph_hi = a.ph_hi;
    __syncthreads();
    if (MK_ONE_LAUNCH) (void)xcd_barrier_post((unsigned*)(a.ws + WS_BAR), (volatile LAS unsigned*)(lds + BST_OFF));
    for (int ph = a.ph_lo; ph < ph_hi; ++ph) {
        if (ph == 0) {
            p0_prologue(lds, G, bid);
        }
        else {
            const int l = (ph - 1) / 5, sp = (ph - 1) % 5;
            unsigned char* ws = ldp<unsigned char>(lds, 17);
            bf16* xb = (bf16*)(ws + WS_XB); float* ss = (float*)(ws + WS_SS); bf16* proj = (bf16*)(ws + WS_PROJ); bf16* mix = (bf16*)(ws + WS_MIX); bf16* hid = (bf16*)(ws + WS_HID);
            if (sp == 1) {
                attn_phase(lds, proj, mix, G, bid);
                asm volatile("" ::: "memory");
                pool_phase(proj, mix, G, bid);
                asm volatile("" ::: "memory");
                conv_phase(lds, proj, mix, PIN(7) + l * 31 * 256, PIN(8) + l * 256, PIN(9) + l * 256, PIN(10) + l * 256, (const bf16*)(ws + WS_WPW) + (size_t)l * 256 * 256, G, bid);
            } else {
                pg8::Gemm g; pg8::EpiAny E; float* outp = ldp<float>(lds, 16);
                E.ss_in = ss; E.ss_out = ss; E.out = outp; E.qg = PIN(3) + l * 64; E.kg = PIN(4) + l * 64;
                if (sp == 0)      { g = pg8::Gemm{xb, (const bf16*)(ws + WS_WIN) + (size_t)l * INC * DM, M_TOK, INC, DM}; E.kind = 0; E.ob = proj; }
                else if (sp == 2) { g = pg8::Gemm{mix, (const bf16*)(ws + WS_WOUT) + (size_t)l * DM * DM, M_TOK, DM, DM}; E.kind = 1; E.ob = xb; }
                else if (sp == 3) { g = pg8::Gemm{xb, (const bf16*)(ws + WS_WGU) + (size_t)l * 2 * FFH * DM, M_TOK, 2 * FFH, DM}; E.kind = 2; E.ob = hid; }
                else              { g = pg8::Gemm{hid, (const bf16*)(ws + WS_WDN) + (size_t)l * DM * FFH, M_TOK, DM, FFH}; E.kind = (l == DEPTH - 1) ? 6 : 1; E.ob = xb; }
                pg8::StaticOrder S; S.init(g.M, g.N, G, bid);
                asm volatile("" ::: "memory");
                pg8::gemm_phase<pg8::EpiAny, pg8::StaticOrder, true, true>(lds, g, S, E);
            }
        }
        if (ph + 1 < ph_hi) { {
            if (ph == 0) cg::this_grid().sync();
            else { XcdBarrier xb; xb.bar = (unsigned*)(ldp<unsigned char>(lds, 17) + WS_BAR); xb.x = xb_xcc_id(); xb.st = (volatile LAS unsigned*)(lds + BST_OFF); xcd_barrier(xb); } } }
    }
}

extern "C" void kernel_launch(void* const* d_in, const int* in_sizes, int n_in, void* d_out, int out_size, void* d_ws, size_t ws_size, hipStream_t stream) {
    static int grid = 0;
    if (grid == 0) {
        if (n_in != 16 || in_sizes[0] != M_TOK * DM || out_size != M_TOK * DM || ws_size < WS_END) { fprintf(stderr, "kernel_launch: unexpected shapes (n_in %d, in0 %d, out %d, ws %zu)\n", n_in, n_in > 0 ? in_sizes[0] : -1, out_size, ws_size); grid = -1; return; }
        int dev = 0, cus = 0, per_cu = 0;
        if (hipGetDevice(&dev) != hipSuccess || hipDeviceGetAttribute(&cus, hipDeviceAttributeMultiprocessorCount, dev) != hipSuccess) { grid = -1; return; }
        if (hipFuncSetAttribute((const void*)mk_fwd, hipFuncAttributeMaxDynamicSharedMemorySize, LDS_BYTES) != hipSuccess) { fprintf(stderr, "kernel_launch: hipFuncSetAttribute failed\n"); grid = -1; return; }
        if (hipOccupancyMaxActiveBlocksPerMultiprocessor(&per_cu, (const void*)mk_fwd, NTHREADS, LDS_BYTES) != hipSuccess || per_cu < 1) { fprintf(stderr, "kernel_launch: occupancy query says %d\n", per_cu); per_cu = 1; }
        (void)hipGetLastError();
        grid = cus * per_cu;
    }
    if (grid < 0) return;
    if (MK_ONE_LAUNCH) { if (hipMemsetAsync((char*)d_ws + WS_BAR, 0, 16384, stream) != hipSuccess) { fprintf(stderr, "kernel_launch: memset failed\n"); return; } }
    Args a{};
    for (int i = 0; i < 16; ++i) a.in[i] = (const float*)d_in[i];
    a.out = (float*)d_out; a.ws = (unsigned char*)d_ws;
#if MK_ONE_LAUNCH
    a.ph_lo = 0; a.ph_hi = N_PHASES;
    void* args[] = {&a};
    hipError_t e = hipLaunchCooperativeKernel((const void*)mk_fwd, dim3(grid), dim3(NTHREADS), args, LDS_BYTES, stream);
    if (e != hipSuccess) fprintf(stderr, "kernel_launch: cooperative launch failed: %s (grid %d)\n", hipGetErrorString(e), grid);
#else
    for (int ph = 0; ph < N_PHASES; ++ph) { a.ph_lo = ph; a.ph_hi = ph + 1; hipLaunchKernelGGL(mk_fwd, dim3(grid), dim3(NTHREADS), LDS_BYTES, stream, a); }
#endif
}
```
